# Optimizing an MI355X kernel written in HIP

```python
import math
import jax, jax.numpy as jnp
from jax import lax
import numpy as np

D_MODEL = 1024
BATCH = 2
SEQ = 16384
DEPTH = 1
DEC_BATCH = 8
DEC_SEQ = 4096
PAST_LEN = 128

MIX_WIDTH = D_MODEL
CONV_CH = MIX_WIDTH // 2
CONV_GROUPS = 8
CONV_K = 3
N_HEADS = 8
V_HEAD = (MIX_WIDTH - CONV_CH) // N_HEADS
QK_NOPE = 64
QK_ROPE = 32
Q_LORA = D_MODEL // 4
KV_LORA = D_MODEL // 8
ROPE_BASE = 10000.0
ATTN_BLOCK = 128
IN_COLS = 3 * CONV_CH + Q_LORA + KV_LORA + QK_ROPE
PEER_HEADS = 8
PEER_NKEYS = 128
PEER_N = PEER_NKEYS * PEER_NKEYS
PEER_DKEY = 256
PEER_TOPK = 16
PEER_CHUNK = 128
ALPHA = (2.0 * DEPTH) ** 0.25
BETA = (8.0 * DEPTH) ** -0.25
LN_EPS = 1e-5
RMS_EPS = 1e-6

kernel_name = "hybrid_conv_mla_peer_encoder"


def _layernorm(x, g, b):
    xf = x.astype(jnp.float32)
    mu = jnp.mean(xf, axis=-1, keepdims=True)
    var = jnp.mean(jnp.square(xf - mu), axis=-1, keepdims=True)
    return ((xf - mu) * lax.rsqrt(var + LN_EPS) * g.astype(jnp.float32) + b.astype(jnp.float32)).astype(x.dtype)


def _rmsnorm(x, g):
    xf = x.astype(jnp.float32)
    ms = jnp.mean(jnp.square(xf), axis=-1, keepdims=True)
    return (xf * lax.rsqrt(ms + RMS_EPS) * g.astype(jnp.float32)).astype(x.dtype)


def _rope_tables(seq_len):
    inv = 1.0 / (ROPE_BASE ** (jnp.arange(0, QK_ROPE, 2, dtype=jnp.float32) / QK_ROPE))
    ang = jnp.arange(seq_len, dtype=jnp.float32)[:, None] * inv[None, :]
    return jnp.cos(ang), jnp.sin(ang)


def _apply_rope(x, cos, sin):
    x1, x2 = jnp.split(x.astype(jnp.float32), 2, axis=-1)
    return jnp.concatenate([x1 * cos - x2 * sin, x1 * sin + x2 * cos], axis=-1).astype(x.dtype)


def _short_conv(h, b_gate, c_gate, conv_w):
    u = c_gate * h
    y = lax.conv_general_dilated(
        u, conv_w[:, None, :].astype(u.dtype), window_strides=(1,),
        padding=[(CONV_K // 2, CONV_K // 2)],
        dimension_numbers=("NWC", "WIO", "NWC"),
        feature_group_count=CONV_CH)
    return b_gate * y


def _mla(q_lat, kv_lat, k_rope, q_norm_g, w_uq, kv_norm_g, w_ukv):
    bn, s_len, _ = q_lat.shape
    q = (_rmsnorm(q_lat, q_norm_g) @ w_uq).reshape(bn, s_len, N_HEADS, QK_NOPE + QK_ROPE)
    q_nope, q_rope = q[..., :QK_NOPE], q[..., QK_NOPE:]
    kv = (_rmsnorm(kv_lat, kv_norm_g) @ w_ukv).reshape(bn, s_len, N_HEADS, QK_NOPE + V_HEAD)
    k_nope, v = kv[..., :QK_NOPE], kv[..., QK_NOPE:]
    cos, sin = _rope_tables(s_len)
    q_rope = _apply_rope(q_rope, cos[:, None, :], sin[:, None, :])
    k_rope = _apply_rope(k_rope, cos, sin)
    scale = (QK_NOPE + QK_ROPE) ** -0.5
    n_blocks = s_len // ATTN_BLOCK

    def block(i):
        start = i * ATTN_BLOCK
        qn = lax.dynamic_slice_in_dim(q_nope, start, ATTN_BLOCK, axis=1)
        qr = lax.dynamic_slice_in_dim(q_rope, start, ATTN_BLOCK, axis=1)
        s = (jnp.einsum("bqhd,bkhd->bhqk", qn, k_nope, preferred_element_type=jnp.float32)
             + jnp.einsum("bqhr,bkr->bhqk", qr, k_rope, preferred_element_type=jnp.float32))
        p = jax.nn.softmax(s * scale, axis=-1).astype(v.dtype)
        return jnp.einsum("bhqk,bkhd->bqhd", p, v)

    o = lax.map(block, jnp.arange(n_blocks))
    return o.transpose(1, 0, 2, 3, 4).reshape(bn, s_len, N_HEADS * V_HEAD)


def _peer(x, wq, k1, k2, u, v):
    bn, s_len, d = x.shape
    t = x.reshape(-1, d)
    n_tok = t.shape[0]
    half = PEER_DKEY // 2

    def chunk_fn(tc):
        c = tc.shape[0]
        q = (tc @ wq).reshape(c, PEER_HEADS, 2, half)
        s1 = jnp.einsum("thd,hnd->thn", q[:, :, 0], k1, preferred_element_type=jnp.float32)
        s2 = jnp.einsum("thd,hnd->thn", q[:, :, 1], k2, preferred_element_type=jnp.float32)
        v1, i1 = lax.top_k(s1, PEER_TOPK)
        v2, i2 = lax.top_k(s2, PEER_TOPK)
        cand = (v1[..., :, None] + v2[..., None, :]).reshape(c, PEER_HEADS, PEER_TOPK * PEER_TOPK)
        cidx = (i1[..., :, None] * PEER_NKEYS + i2[..., None, :]).reshape(c, PEER_HEADS, PEER_TOPK * PEER_TOPK)
        best, pos = lax.top_k(cand, PEER_TOPK)
        eidx = jnp.take_along_axis(cidx, pos, axis=-1)
        g = jax.nn.softmax(best, axis=-1)
        a = jax.nn.gelu(jnp.einsum("td,thkd->thk", tc, u[eidx]).astype(jnp.float32), approximate=False)
        coef = (g * a).astype(v.dtype)
        return jnp.einsum("thk,thkd->td", coef, v[eidx])

    out = lax.map(chunk_fn, t.reshape(n_tok // PEER_CHUNK, PEER_CHUNK, d))
    return out.reshape(bn, s_len, d)


def _layer(x, w_in, conv_w, q_norm_g, w_uq, kv_norm_g, w_ukv, w_o, ln1_g, ln1_b,
           peer_wq, peer_k1, peer_k2, peer_u, peer_v, ln2_g, ln2_b):
    z = x @ w_in
    o1 = CONV_CH
    o2 = 2 * CONV_CH
    o3 = 3 * CONV_CH
    o4 = o3 + Q_LORA
    o5 = o4 + KV_LORA
    b_gate, c_gate, h, q_lat, kv_lat, k_rope = jnp.split(z, [o1, o2, o3, o4, o5], axis=-1)
    conv_out = _short_conv(h, b_gate, c_gate, conv_w)
    attn_out = _mla(q_lat, kv_lat, k_rope, q_norm_g, w_uq, kv_norm_g, w_ukv)
    mix = jnp.concatenate([conv_out, attn_out], axis=-1) @ w_o
    x = _layernorm(ALPHA * x + mix, ln1_g, ln1_b)
    x = _layernorm(ALPHA * x + _peer(x, peer_wq, peer_k1, peer_k2, peer_u, peer_v), ln2_g, ln2_b)
    return x


def setup_inputs(seed: int = 0) -> dict:
    key = jax.random.key(seed)
    ks = jax.random.split(key, 24)
    f32 = jnp.float32
    nrm = lambda k, shape, s: jax.random.normal(k, shape, f32) * s
    L = DEPTH
    return {
        "x_prompt": jax.random.normal(ks[0], (BATCH, SEQ, D_MODEL), f32),
        "x_sample": jax.random.normal(ks[1], (DEC_BATCH, DEC_SEQ, D_MODEL), f32),
        "w_in": nrm(ks[2], (L, D_MODEL, IN_COLS), D_MODEL ** -0.5),
        "conv_w": nrm(ks[3], (L, CONV_K, CONV_CH), CONV_K ** -0.5),
        "q_norm_g": 1.0 + nrm(ks[4], (L, Q_LORA), 0.02),
        "w_uq": nrm(ks[5], (L, Q_LORA, N_HEADS * (QK_NOPE + QK_ROPE)), Q_LORA ** -0.5),
        "kv_norm_g": 1.0 + nrm(ks[6], (L, KV_LORA), 0.02),
        "w_ukv": nrm(ks[7], (L, KV_LORA, N_HEADS * (QK_NOPE + V_HEAD)), KV_LORA ** -0.5),
        "w_o": nrm(ks[8], (L, MIX_WIDTH, D_MODEL), BETA * MIX_WIDTH ** -0.5),
        "ln1_g": 1.0 + nrm(ks[9], (L, D_MODEL), 0.02),
        "ln1_b": nrm(ks[10], (L, D_MODEL), 0.02),
        "peer_wq": nrm(ks[11], (L, D_MODEL, PEER_HEADS * PEER_DKEY), D_MODEL ** -0.5),
        "peer_k1": nrm(ks[12], (L, PEER_HEADS, PEER_NKEYS, PEER_DKEY // 2), (PEER_DKEY // 2) ** -0.5),
        "peer_k2": nrm(ks[13], (L, PEER_HEADS, PEER_NKEYS, PEER_DKEY // 2), (PEER_DKEY // 2) ** -0.5),
        "peer_u": nrm(ks[14], (L, PEER_N, D_MODEL), D_MODEL ** -0.5),
        "peer_v": nrm(ks[15], (L, PEER_N, D_MODEL), BETA * PEER_HEADS ** -0.5),
        "ln2_g": 1.0 + nrm(ks[16], (L, D_MODEL), 0.02),
        "ln2_b": nrm(ks[17], (L, D_MODEL), 0.02),
    }


def reference(x_prompt, x_sample, w_in, conv_w, q_norm_g, w_uq, kv_norm_g, w_ukv, w_o,
              ln1_g, ln1_b, peer_wq, peer_k1, peer_k2, peer_u, peer_v, ln2_g, ln2_b):
    y_prompt = x_prompt
    y_sample = x_sample
    for l in range(DEPTH):
        y_prompt = _layer(y_prompt, w_in[l], conv_w[l], q_norm_g[l], w_uq[l], kv_norm_g[l], w_ukv[l],
                          w_o[l], ln1_g[l], ln1_b[l], peer_wq[l], peer_k1[l], peer_k2[l],
                          peer_u[l], peer_v[l], ln2_g[l], ln2_b[l])
        y_sample = _layer(y_sample, w_in[l], conv_w[l], q_norm_g[l], w_uq[l], kv_norm_g[l], w_ukv[l],
                          w_o[l], ln1_g[l], ln1_b[l], peer_wq[l], peer_k1[l], peer_k2[l],
                          peer_u[l], peer_v[l], ln2_g[l], ln2_b[l])
    return (y_prompt, y_sample)
```

```cpp
#include <hip/hip_runtime.h>
#include <hip/hip_cooperative_groups.h>
#include <cstdio>
#include <cmath>
namespace cg = cooperative_groups;

#define DI __device__ __forceinline__
typedef __attribute__((ext_vector_type(8))) short bf16x8;
typedef __attribute__((ext_vector_type(16))) float f32x16;
typedef __attribute__((ext_vector_type(4))) float f32x4;
typedef __attribute__((ext_vector_type(2))) float f32x2;
typedef __attribute__((ext_vector_type(4))) unsigned u32x4;
typedef __attribute__((ext_vector_type(2))) unsigned u32x2;
typedef __attribute__((ext_vector_type(4))) int i32x4;
typedef __attribute__((ext_vector_type(2))) __bf16 bf16x2_t;
typedef unsigned short bfu;
typedef __attribute__((ext_vector_type(8))) int i32x8;

#ifndef MULTI_LAUNCH
#define MULTI_LAUNCH 0
#endif

constexpr int T = 65536;
constexpr int TPROMPT = 32768;
constexpr int INC = 1952;
constexpr float ALPHA = 1.189207115002721f;
constexpr float LN_EPS = 1e-5f;
constexpr float RMS_EPS = 1e-6f;
constexpr size_t MiB = 1ull << 20;
constexpr size_t OFF_WIN = 0;
constexpr size_t OFF_WO = 4 * MiB;
constexpr size_t OFF_WQ = 6 * MiB;
constexpr size_t OFF_WUQ = 10 * MiB;
constexpr size_t OFF_WUKV = 10 * MiB + 512 * 1024;
constexpr size_t OFF_K1 = 10 * MiB + 768 * 1024;
constexpr size_t OFF_K2 = 11 * MiB;
constexpr size_t OFF_ROPE = 11 * MiB + 256 * 1024;
constexpr size_t OFF_BAR = 13 * MiB + 512 * 1024;
constexpr size_t OFF_Z = 14 * MiB;
constexpr size_t OFF_XB = 258 * MiB;
constexpr size_t OFF_QH = 258 * MiB;
constexpr size_t OFF_KH = 354 * MiB;
constexpr size_t OFF_Y1 = 14 * MiB;
constexpr size_t OFF_X1B = 270 * MiB;
constexpr size_t OFF_UB = 398 * MiB;
constexpr size_t OFF_VB = 414 * MiB;
constexpr size_t OFF_PART = 14 * MiB;
constexpr float U_SCALE = 54.f, V_SCALE = 8.f;
constexpr size_t OFF_QP = 14 * MiB;
constexpr size_t OFF_EIDX = 430 * MiB;
constexpr size_t OFF_GW = 462 * MiB;
constexpr size_t OUT_OFF_VT = 128 * MiB;

constexpr int GP = 144;
constexpr int NT = 512, NW = 8;
constexpr int GBUF = 256 * 128;
constexpr int EP = 68;
constexpr int SMEM_RS = 8 * 64 * EP * 4;
constexpr int SMEM_BYTES = SMEM_RS + 1024;

struct Params {
  const float* xp; const float* xs; const float* w_in; const float* conv_w; const float* qng; const float* w_uq;
  const float* kvng; const float* w_ukv; const float* w_o; const float* ln1g; const float* ln1b; const float* pwq;
  const float* pk1; const float* pk2; const float* pu; const float* pv; const float* ln2g; const float* ln2b;
  float* out; char* ws;
  double inv_freq[16];
};

DI int opaque_tid() { int t = threadIdx.x; asm volatile("" : "+v"(t)); return t; }
DI unsigned pk2(float a, float b) { f32x2 v = {a, b}; bf16x2_t r = __builtin_convertvector(v, bf16x2_t); return __builtin_bit_cast(unsigned, r); }
DI bfu f2bf(float a) { return (bfu)(pk2(a, 0.f) & 0xffffu); }
DI float bflo(unsigned w) { return __uint_as_float(w << 16); }
DI float bfhi(unsigned w) { return __uint_as_float(w & 0xffff0000u); }
DI unsigned pk4_fp8(float a, float b, float c, float d) { int w = __builtin_amdgcn_cvt_pk_fp8_f32(a, b, 0, false); w = __builtin_amdgcn_cvt_pk_fp8_f32(c, d, w, true); return (unsigned)w; }
DI float bf2f(bfu h) { return __uint_as_float(((unsigned)h) << 16); }
DI f32x16 mfma32(bf16x8 a, bf16x8 b, f32x16 c) { return __builtin_amdgcn_mfma_f32_32x32x16_bf16(a, b, c, 0, 0, 0); }
DI int crow(int i, int hf) { return (i & 3) + 8 * (i >> 2) + 4 * hf; }
DI float wave_sum(float v) {
#pragma unroll
  for (int o = 32; o >= 1; o >>= 1) v += __shfl_xor(v, o);
  return v;
}
DI void tok_geom(int t, int& seq_start, int& pos, int& S) {
  if (t < TPROMPT) { S = 16384; seq_start = t & ~16383; pos = t & 16383; }
  else { S = 4096; seq_start = t & ~4095; pos = t & 4095; }
}
DI const float* xrow(const Params& p, int t) { return t < TPROMPT ? p.xp + (size_t)t * 1024 : p.xs + (size_t)(t - TPROMPT) * 1024; }

DI void transpose_cvt(const float* __restrict__ src, bfu* __restrict__ dst, int K, int N, const float* __restrict__ gain, float scal, float* tile) {
  const int tn = N / 32, ntile = (K / 32) * tn;
  const int tq = opaque_tid(), tx = tq & 31, ty = tq >> 5;
  for (int tl = blockIdx.x; tl < ntile; tl += gridDim.x) {
    const int k0 = (tl / tn) * 32, n0 = (tl % tn) * 32;
    __syncthreads();
    for (int i = ty; i < 32; i += 16) { float g = gain ? gain[k0 + i] : 1.f; tile[i * 33 + tx] = src[(size_t)(k0 + i) * N + n0 + tx] * g * scal; }
    __syncthreads();
    for (int i = ty; i < 32; i += 16) dst[(size_t)(n0 + i) * K + k0 + tx] = f2bf(tile[tx * 33 + i]);
  }
}

DI void phase0(const Params& p, char* smem) {
  float* tile = (float*)smem;
  const float qscale = 0.10206207261596575f * 1.4426950408889634f;
  transpose_cvt(p.w_in, (bfu*)(p.ws + OFF_WIN), 1024, 1952, nullptr, 1.f, tile);
  transpose_cvt(p.w_o, (bfu*)(p.ws + OFF_WO), 1024, 1024, nullptr, 1.f, tile);
  transpose_cvt(p.pwq, (bfu*)(p.ws + OFF_WQ), 1024, 2048, nullptr, 1.f, tile);
  transpose_cvt(p.w_uq, (bfu*)(p.ws + OFF_WUQ), 256, 768, p.qng, qscale, tile);
  transpose_cvt(p.w_ukv, (bfu*)(p.ws + OFF_WUKV), 128, 1024, p.kvng, 1.f, tile);
  const int gtid = blockIdx.x * NT + opaque_tid(), gstride = gridDim.x * NT;
  bfu* k1b = (bfu*)(p.ws + OFF_K1); bfu* k2b = (bfu*)(p.ws + OFF_K2);
  for (int i = gtid; i < 8 * 128 * 128; i += gstride) { k1b[i] = f2bf(p.pk1[i]); k2b[i] = f2bf(p.pk2[i]); }
  bfu* xb = (bfu*)(p.ws + OFF_XB);
  for (int i = gtid; i < T * 128; i += gstride) {
    const float* src = xrow(p, i >> 7) + (i & 127) * 8;
    const f32x4 a = *(const f32x4*)src, b = *(const f32x4*)(src + 4);
    *(u32x4*)(xb + (size_t)i * 8) = u32x4{pk2(a[0], a[1]), pk2(a[2], a[3]), pk2(b[0], b[1]), pk2(b[2], b[3])};
  }
  f32x2* rope = (f32x2*)(p.ws + OFF_ROPE);
  for (int i = gtid; i < 16384 * 16; i += gstride) {
    const int pos = i >> 4, f = i & 15;
    double rev = (double)pos * p.inv_freq[f] * 0.15915494309189535;
    rev -= __builtin_rint(rev);
    const float fr = (float)rev;
    f32x2 cs = {__builtin_amdgcn_cosf(fr), __builtin_amdgcn_sinf(fr)};
    rope[i] = cs;
  }
}

DI void dma16(const void* src, char* lds_wave_base) { __builtin_amdgcn_global_load_lds((const unsigned*)src, (__attribute__((address_space(3))) unsigned*)lds_wave_base, 16, 0, 0); }
template <bool TRW1, class Epi>
DI void gemm_tile(const bfu* __restrict__ A, int lda, const bfu* __restrict__ Bt, int ldb, int K, int nrowsB, char* smem, Epi epi) {
  const int tid = opaque_tid(), lane = tid & 63, w = tid >> 6, wm = w >> 2, wn = w & 3;
  const int l31 = lane & 31, hf = lane >> 5;
  f32x16 acc[4][2];
#pragma unroll
  for (int i = 0; i < 4; ++i)
#pragma unroll
    for (int j = 0; j < 2; ++j)
#pragma unroll
      for (int r = 0; r < 16; ++r) acc[i][j][r] = 0.f;
  const int srow = lane >> 3, spos = lane & 7;
  const bfu* ap[4]; const bfu* bp[4];
#pragma unroll
  for (int i = 0; i < 4; ++i) {
    const int r = 8 * (w * 4 + i) + srow, c = spos ^ srow ^ (i & 1);
    ap[i] = A + (size_t)r * lda + c * 8;
    const int rB = r < nrowsB ? r : nrowsB - 1;
    bp[i] = Bt + (size_t)rB * ldb + c * 8;
  }
  auto stage = [&](int k0, int buf) {
#pragma unroll
    for (int i = 0; i < 4; ++i) {
      dma16(ap[i] + k0, smem + buf * GBUF + (w * 4 + i) * 1024);
      dma16(bp[i] + k0, smem + (2 + buf) * GBUF + (w * 4 + i) * 1024);
    }
  };
  const int nk = K / 64;
  const int xr = (l31 & 7) ^ ((l31 >> 3) & 1);
  __syncthreads();
  stage(0, 0);
  asm volatile("s_waitcnt vmcnt(0)" ::: "memory");
  __syncthreads();
#pragma unroll 1
  for (int kt = 0; kt < nk; ++kt) {
    if (kt + 1 < nk) stage((kt + 1) * 64, (kt + 1) & 1);
    const char* As = smem + (kt & 1) * GBUF + (wm * 128 + l31) * 128;
    const char* Bs = smem + (2 + (kt & 1)) * GBUF + (wn * 64 + l31) * 128;
#pragma unroll
    for (int s = 0; s < 4; ++s) {
      const int co = ((2 * s + hf) ^ xr) * 16;
      bf16x8 a[4], b[2];
#pragma unroll
      for (int i = 0; i < 4; ++i) a[i] = *(const bf16x8*)(As + i * 32 * 128 + co);
#pragma unroll
      for (int j = 0; j < 2; ++j) b[j] = *(const bf16x8*)(Bs + j * 32 * 128 + co);
#pragma unroll
      for (int i = 0; i < 4; ++i)
#pragma unroll
        for (int j = 0; j < 2; ++j) acc[i][j] = mfma32(a[i], b[j], acc[i][j]);
    }
    asm volatile("s_waitcnt vmcnt(0)" ::: "memory");
    __syncthreads();
  }
  float* st = (float*)(smem + w * (64 * EP * 4));
#pragma unroll
  for (int ps = 0; ps < 2; ++ps) {
    if (TRW1 && (wn & 1)) {
#pragma unroll
      for (int i = 0; i < 2; ++i)
#pragma unroll
        for (int j = 0; j < 2; ++j)
#pragma unroll
          for (int g = 0; g < 4; ++g)
            *(f32x4*)(st + (j * 32 + l31) * EP + i * 32 + 8 * g + 4 * hf) = f32x4{acc[2 * ps + i][j][4 * g], acc[2 * ps + i][j][4 * g + 1], acc[2 * ps + i][j][4 * g + 2], acc[2 * ps + i][j][4 * g + 3]};
#pragma unroll 8
      for (int it = 0; it < 16; ++it) {
        const int c = it * 4 + (lane >> 4), r4 = 4 * (lane & 15);
        const f32x4 v = *(const f32x4*)(st + c * EP + r4);
        epi(wm * 128 + ps * 64 + r4, wn * 64 + c, v, true);
      }
    } else {
#pragma unroll
      for (int i = 0; i < 2; ++i)
#pragma unroll
        for (int j = 0; j < 2; ++j)
#pragma unroll
          for (int r = 0; r < 16; ++r) st[(i * 32 + crow(r, hf)) * EP + j * 32 + l31] = acc[2 * ps + i][j][r];
#pragma unroll 8
      for (int it = 0; it < 16; ++it) {
        const int r = it * 4 + (lane >> 4), c4 = 4 * (lane & 15);
        const f32x4 v = *(const f32x4*)(st + r * EP + c4);
        epi(wm * 128 + ps * 64 + r, wn * 64 + c4, v, false);
      }
    }
  }
}

DI void tile_map(int idx, int NT, int& mt, int& nt) { const int x = idx & 7, j = idx >> 3; mt = (j / NT) * 8 + x; nt = j % NT; }

DI void phase1(const Params& p, char* smem) {
  const bfu* wt = (const bfu*)(p.ws + OFF_WIN);
  bfu* z = (bfu*)(p.ws + OFF_Z);
  const int lane = opaque_tid() & 63, l31 = lane & 31, hf = lane >> 5;
  for (int idx = blockIdx.x; idx < 256 * 8; idx += gridDim.x) {
    int mt, nt; tile_map(idx, 8, mt, nt);
    const int m0 = mt * 256, n0 = nt * 256;
    gemm_tile<false>((const bfu*)(p.ws + OFF_XB) + (size_t)m0 * 1024, 1024, wt + (size_t)n0 * 1024, 1024, 1024, INC - n0, smem,
      [&](int rl, int cl, const f32x4& v, bool) {
        if (n0 + cl < INC) *(u32x2*)(z + (size_t)(m0 + rl) * INC + n0 + cl) = u32x2{pk2(v[0], v[1]), pk2(v[2], v[3])};
      });
  }
}

DI void rms_rows(const bfu* zsrc, int width, float* rs) {
  const int tid = opaque_tid(), row = tid >> 1, half = tid & 1;
  const bfu* src = zsrc + (size_t)row * INC + half * (width / 2);
  float ss = 0.f;
  for (int c = 0; c < width / 2; c += 8) {
    const u32x4 v = *(const u32x4*)(src + c);
#pragma unroll
    for (int k = 0; k < 4; ++k) { const float a = bflo(v[k]), b = bfhi(v[k]); ss += a * a + b * b; }
  }
  ss += __shfl_xor(ss, 1);
  if (half == 0) rs[row] = rsqrtf(ss / (float)width + RMS_EPS);
}

DI void phase2(const Params& p, char* smem) {
  const bfu* z = (const bfu*)(p.ws + OFF_Z);
  bfu* mix = (bfu*)p.out;
  bfu* qh = (bfu*)(p.ws + OFF_QH);
  bfu* kh = (bfu*)(p.ws + OFF_KH);
  bfu* vT = (bfu*)((char*)p.out + OUT_OFF_VT);
  const f32x2* rope = (const f32x2*)(p.ws + OFF_ROPE);
  const int tid = opaque_tid(), lane = tid & 63, l31 = lane & 31, hf = lane >> 5;
  for (int it = blockIdx.x; it < T * 64 / NT; it += gridDim.x) {
    const int idx = it * NT + tid, t = idx >> 6, cc = (idx & 63) * 8;
    int ss, pos, S; tok_geom(t, ss, pos, S);
    const bfu* zr = z + (size_t)t * INC;
    const u32x4 bg = *(const u32x4*)(zr + cc);
    float y[8];
#pragma unroll
    for (int k = 0; k < 8; ++k) y[k] = 0.f;
#pragma unroll
    for (int dk = 0; dk < 3; ++dk) {
      const int pp = pos + dk - 1;
      if (pp >= 0 && pp < S) {
        const bfu* zn = zr + (ptrdiff_t)(dk - 1) * INC;
        const u32x4 cg_ = *(const u32x4*)(zn + 512 + cc), hg = *(const u32x4*)(zn + 1024 + cc);
        const f32x4 w0 = *(const f32x4*)(p.conv_w + dk * 512 + cc), w1 = *(const f32x4*)(p.conv_w + dk * 512 + cc + 4);
#pragma unroll
        for (int k = 0; k < 4; ++k) {
          const float wl = k < 2 ? w0[2 * k] : w1[2 * k - 4], wh = k < 2 ? w0[2 * k + 1] : w1[2 * k - 3];
          y[2 * k] += wl * bflo(cg_[k]) * bflo(hg[k]);
          y[2 * k + 1] += wh * bfhi(cg_[k]) * bfhi(hg[k]);
        }
      }
    }
    u32x4 o;
#pragma unroll
    for (int k = 0; k < 4; ++k) o[k] = pk2(bflo(bg[k]) * y[2 * k], bfhi(bg[k]) * y[2 * k + 1]);
    *(u32x4*)(mix + (size_t)t * 1024 + cc) = o;
  }
  for (int it = blockIdx.x; it < T * 16 / NT; it += gridDim.x) {
    const int idx = it * NT + tid, t = idx >> 4, f = idx & 15;
    int ss, pos, S; tok_geom(t, ss, pos, S);
    const float x1 = bf2f(z[(size_t)t * INC + 1920 + f]), x2 = bf2f(z[(size_t)t * INC + 1936 + f]);
    const f32x2 cs = rope[pos * 16 + f];
    const bfu o1 = f2bf(x1 * cs[0] - x2 * cs[1]), o2 = f2bf(x1 * cs[1] + x2 * cs[0]);
#pragma unroll
    for (int h = 0; h < 8; ++h) { bfu* d = kh + ((size_t)h * T + t) * 96 + 64 + f; d[0] = o1; d[16] = o2; }
  }
  float* rs = (float*)(smem + SMEM_RS);
  {
    const bfu* wt = (const bfu*)(p.ws + OFF_WUQ);
    for (int idx = blockIdx.x; idx < 256 * 3; idx += gridDim.x) {
      int mt, nt; tile_map(idx, 3, mt, nt);
      const int m0 = mt * 256, n0 = nt * 256;
      __syncthreads();
      rms_rows(z + (size_t)m0 * INC + 1536, 256, rs);
      gemm_tile<false>(z + (size_t)m0 * INC + 1536, INC, wt + (size_t)n0 * 256, 256, 256, 256, smem,
        [&](int rl, int cl, const f32x4& vin, bool) {
          const int col = n0 + cl, head = col / 96, d = col - head * 96, t = m0 + rl;
          const float sc = rs[rl];
          f32x4 v = vin * sc;
          f32x4 pr;
#pragma unroll
          for (int k = 0; k < 4; ++k) pr[k] = __shfl_xor(v[k], 4);
          if (d >= 64) {
            int ss, pos, S; tok_geom(t, ss, pos, S);
            const int f = (d - 64) & 15;
            const f32x4 cs0 = *(const f32x4*)(rope + pos * 16 + f), cs1 = *(const f32x4*)(rope + pos * 16 + f + 2);
            const float co[4] = {cs0[0], cs0[2], cs1[0], cs1[2]}, si[4] = {cs0[1], cs0[3], cs1[1], cs1[3]};
            const bool first = d < 80;
#pragma unroll
            for (int k = 0; k < 4; ++k) v[k] = first ? v[k] * co[k] - pr[k] * si[k] : pr[k] * si[k] + v[k] * co[k];
          }
          *(u32x2*)(qh + ((size_t)head * T + t) * 96 + d) = u32x2{pk2(v[0], v[1]), pk2(v[2], v[3])};
        });
    }
  }
  {
    const bfu* wt = (const bfu*)(p.ws + OFF_WUKV);
    for (int idx = blockIdx.x; idx < 256 * 4; idx += gridDim.x) {
      int mt, nt; tile_map(idx, 4, mt, nt);
      const int m0 = mt * 256, n0 = nt * 256;
      __syncthreads();
      rms_rows(z + (size_t)m0 * INC + 1792, 128, rs);
      gemm_tile<true>(z + (size_t)m0 * INC + 1792, INC, wt + (size_t)n0 * 128, 128, 128, 256, smem,
        [&](int rl, int cl, const f32x4& v, bool tr) {
          const int head = (n0 + cl) >> 7, dd = cl & 127;
          if (!tr) {
            const float sc = rs[rl];
            *(u32x2*)(kh + ((size_t)head * T + m0 + rl) * 96 + dd) = u32x2{pk2(v[0] * sc, v[1] * sc), pk2(v[2] * sc, v[3] * sc)};
          } else {
            const f32x4 sc = *(const f32x4*)(rs + rl);
            const int tk = m0 + rl, key = tk & 63;
            const int pos = 32 * ((key >> 3) & 1) + 16 * (key >> 5) + 8 * ((key >> 4) & 1) + (key & 7);
            *(unsigned*)((unsigned char*)vT + (((size_t)head * (T / 64) + (tk >> 6)) * 64 + (dd - 64)) * 64 + pos) = pk4_fp8(v[0] * sc[0], v[1] * sc[1], v[2] * sc[2], v[3] * sc[3]);
          }
        });
    }
  }
}

DI void attn_item64(const Params& p, int seq_start, int S, int h, int q0, char* smem) {
  const int tid = opaque_tid(), lane = tid & 63, w = tid >> 6, l31 = lane & 31, hf = lane >> 5;
  const bfu* qh = (const bfu*)(p.ws + OFF_QH);
  const bfu* kh = (const bfu*)(p.ws + OFF_KH);
  const bfu* vT = (const bfu*)((const char*)p.out + OUT_OFF_VT);
  constexpr int KB = 64 * 208, VB = 64 * 80;
  char* qsp = smem + 2 * KB + 2 * VB + w * 12288 + lane * 16;
  {
    const bfu* qrow0 = qh + ((size_t)h * T + q0 + 64 * w + l31) * 96 + 8 * hf;
    const bfu* qrow1 = qrow0 + 32 * 96;
#pragma unroll
    for (int ks = 0; ks < 6; ++ks) { *(bf16x8*)(qsp + ks * 1024) = *(const bf16x8*)(qrow0 + 16 * ks); *(bf16x8*)(qsp + 6144 + ks * 1024) = *(const bf16x8*)(qrow1 + 16 * ks); }
  }
  f32x16 o[2][2];
#pragma unroll
  for (int a = 0; a < 2; ++a)
#pragma unroll
    for (int d = 0; d < 2; ++d)
#pragma unroll
      for (int r = 0; r < 16; ++r) o[a][d][r] = 0.f;
  float m[2] = {0.f, 0.f}, lsum[2] = {0.f, 0.f};
  bf16x8 qm[2], kone;
#pragma unroll
  for (int r = 0; r < 8; ++r) { qm[0][r] = 0; qm[1][r] = 0; kone[r] = 0; }
  if (hf == 0) kone[0] = (short)0x3F80;
  const char* kbase = (const char*)(kh + ((size_t)h * T + seq_start) * 96);
  const unsigned char* vbase = (const unsigned char*)vT + ((size_t)h * (T / 64) + (seq_start >> 6)) * 4096;
  u32x4 rk[2]; u32x2 rv;
  auto gload = [&](int kt) {
    const char* kp = kbase + (size_t)kt * 12288;
    rk[0] = *(const u32x4*)(kp + tid * 16);
    if (tid < 256) rk[1] = *(const u32x4*)(kp + (tid + NT) * 16);
    rv = *(const u32x2*)(vbase + (size_t)kt * 4096 + tid * 8);
  };
  auto swrite = [&](int buf) {
    { const int key = tid / 12, part = tid % 12; *(u32x4*)(smem + buf * KB + key * 208 + part * 16) = rk[0]; }
    if (tid < 256) { const int c = tid + NT, key = c / 12, part = c % 12; *(u32x4*)(smem + buf * KB + key * 208 + part * 16) = rk[1]; }
    { const int d = tid >> 3, part = tid & 7; *(u32x2*)(smem + 2 * KB + buf * VB + d * 80 + part * 8) = rv; }
  };
  const int prow = (l31 & 0x13) | ((l31 & 4) << 1) | ((l31 & 8) >> 1);
  const int nkt = S / 64;
  __syncthreads();
  gload(0); swrite(0);
  __syncthreads();
#pragma unroll 1
  for (int kt = 0; kt < nkt; ++kt) {
    if (kt + 1 < nkt) gload(kt + 1);
    const char* Ks = smem + (kt & 1) * KB + prow * 208 + hf * 16;
    const char* Vs = smem + 2 * KB + (kt & 1) * VB + l31 * 80 + hf * 32;
    f32x16 s[2][2];
    {
      __builtin_amdgcn_s_setprio(1);
      f32x16 zz;
#pragma unroll
      for (int r = 0; r < 16; ++r) zz[r] = 0.f;
#pragma unroll
      for (int ks = 0; ks < 6; ++ks) {
        const bf16x8 k0 = *(const bf16x8*)(Ks + ks * 32), k1 = *(const bf16x8*)(Ks + 32 * 208 + ks * 32);
        const bf16x8 q0f = *(const bf16x8*)(qsp + ks * 1024), q1 = *(const bf16x8*)(qsp + 6144 + ks * 1024);
        s[0][0] = mfma32(k0, q0f, ks == 0 ? zz : s[0][0]);
        s[0][1] = mfma32(k1, q0f, ks == 0 ? zz : s[0][1]);
        s[1][0] = mfma32(k0, q1, ks == 0 ? zz : s[1][0]);
        s[1][1] = mfma32(k1, q1, ks == 0 ? zz : s[1][1]);
      }
#pragma unroll
      for (int a = 0; a < 2; ++a) { s[a][0] = mfma32(kone, qm[a], s[a][0]); s[a][1] = mfma32(kone, qm[a], s[a][1]); }
      __builtin_amdgcn_s_setprio(0);
    }
    float mx[2];
#pragma unroll
    for (int a = 0; a < 2; ++a) {
      float t = s[a][0][0];
#pragma unroll
      for (int r = 1; r < 16; ++r) t = fmaxf(t, s[a][0][r]);
#pragma unroll
      for (int r = 0; r < 16; ++r) t = fmaxf(t, s[a][1][r]);
      mx[a] = fmaxf(t, __shfl_xor(t, 32));
    }
    const bool need0 = (kt == 0) || (mx[0] > 8.f), need1 = (kt == 0) || (mx[1] > 8.f);
    if (__any(need0 || need1)) {
#pragma unroll
      for (int a = 0; a < 2; ++a) {
        const bool need = a ? need1 : need0;
        const float want = need ? (kt == 0 ? mx[a] : fmaxf(mx[a], 0.f)) : 0.f;
        const unsigned mb = pk2(m[a] + want, 0.f) & 0xffffu;
        const float mnew = __uint_as_float(mb << 16);
        const float delta = mnew - m[a];
        const float alpha = (kt == 0) ? 1.f : __builtin_amdgcn_exp2f(-delta);
        m[a] = mnew;
        lsum[a] *= alpha;
#pragma unroll
        for (int r = 0; r < 16; ++r) { o[a][0][r] *= alpha; o[a][1][r] *= alpha; s[a][0][r] -= delta; s[a][1][r] -= delta; }
        if (hf == 0) qm[a][0] = (short)(mb ^ 0x8000u);
      }
    }
#pragma unroll
    for (int a = 0; a < 2; ++a) {
      i32x8 pb;
      float ps = 0.f;
#pragma unroll
      for (int sub = 0; sub < 2; ++sub)
#pragma unroll
        for (int u = 0; u < 4; ++u) {
          const float e0 = __builtin_amdgcn_exp2f(s[a][sub][4 * u]), e1 = __builtin_amdgcn_exp2f(s[a][sub][4 * u + 1]);
          const float e2 = __builtin_amdgcn_exp2f(s[a][sub][4 * u + 2]), e3 = __builtin_amdgcn_exp2f(s[a][sub][4 * u + 3]);
          ps += (e0 + e1) + (e2 + e3);
          pb[4 * sub + u] = (int)pk4_fp8(e0, e1, e2, e3);
        }
      lsum[a] += ps;
#pragma unroll
      for (int dt = 0; dt < 2; ++dt) {
        const u32x4 lo = *(const u32x4*)(Vs + dt * 32 * 80), hi = *(const u32x4*)(Vs + dt * 32 * 80 + 16);
        const i32x8 va = {(int)lo[0], (int)lo[1], (int)lo[2], (int)lo[3], (int)hi[0], (int)hi[1], (int)hi[2], (int)hi[3]};
        o[a][dt] = __builtin_amdgcn_mfma_scale_f32_32x32x64_f8f6f4(va, pb, o[a][dt], 0, 0, 0, 0x7F7F7F7F, 0, 0x7F7F7F7F);
      }
    }
    if (kt + 1 < nkt) swrite((kt + 1) & 1);
    __syncthreads();
  }
  bfu* mix = (bfu*)p.out;
#pragma unroll
  for (int a = 0; a < 2; ++a) {
    const float lt = lsum[a] + __shfl_xor(lsum[a], 32);
    const float inv = 1.f / lt;
    const int t = q0 + 64 * w + 32 * a + l31;
#pragma unroll
    for (int g = 0; g < 4; ++g) {
      const int d = 8 * g + 4 * hf;
      u32x2 x0 = {pk2(o[a][0][4 * g] * inv, o[a][0][4 * g + 1] * inv), pk2(o[a][0][4 * g + 2] * inv, o[a][0][4 * g + 3] * inv)};
      u32x2 x1 = {pk2(o[a][1][4 * g] * inv, o[a][1][4 * g + 1] * inv), pk2(o[a][1][4 * g + 2] * inv, o[a][1][4 * g + 3] * inv)};
      *(u32x2*)(mix + (size_t)t * 1024 + 512 + h * 64 + d) = x0;
      *(u32x2*)(mix + (size_t)t * 1024 + 512 + h * 64 + 32 + d) = x1;
    }
  }
}

DI void phase3(const Params& p, char* smem) {
  for (int i = blockIdx.x; i < 1024; i += gridDim.x) {
    if (i < 512) { const int qb = i & 31, h = (i >> 5) & 7, sq = i >> 8; attn_item64(p, sq * 16384, 16384, h, sq * 16384 + qb * 512, smem); }
    else { const int j = i - 512, qb = j & 7, h = (j >> 3) & 7, sq = j >> 6; attn_item64(p, TPROMPT + sq * 4096, 4096, h, TPROMPT + sq * 4096 + qb * 512, smem); }
  }
}

DI void phase4(const Params& p, char* smem) {
  const bfu* wt = (const bfu*)(p.ws + OFF_WO);
  const bfu* mix = (const bfu*)p.out;
  bfu* y1 = (bfu*)(p.ws + OFF_Y1);
  const int lane = opaque_tid() & 63, l31 = lane & 31, hf = lane >> 5;
  for (int idx = blockIdx.x; idx < 256 * 4; idx += gridDim.x) {
    int mt, nt; tile_map(idx, 4, mt, nt);
    const int m0 = mt * 256, n0 = nt * 256;
    const float* xr = xrow(p, m0);
    gemm_tile<false>(mix + (size_t)m0 * 1024, 1024, wt + (size_t)n0 * 1024, 1024, 1024, 256, smem,
      [&](int rl, int cl, const f32x4& v, bool) {
        const f32x4 xv = *(const f32x4*)(xr + (size_t)rl * 1024 + n0 + cl);
        const f32x4 y = v + ALPHA * xv;
        *(u32x2*)(y1 + (size_t)(m0 + rl) * 1024 + n0 + cl) = u32x2{pk2(y[0], y[1]), pk2(y[2], y[3])};
      });
  }
}

DI void phase5(const Params& p) {
  const bfu* y1 = (const bfu*)(p.ws + OFF_Y1);
  bfu* x1b = (bfu*)(p.ws + OFF_X1B);
  const int tid = opaque_tid(), lane = tid & 63, w = tid >> 6;
  f32x4 g[4], b[4];
#pragma unroll
  for (int i = 0; i < 4; ++i) { g[i] = *(const f32x4*)(p.ln1g + 4 * lane + 256 * i); b[i] = *(const f32x4*)(p.ln1b + 4 * lane + 256 * i); }
  for (int t = blockIdx.x * NW + w; t < T; t += gridDim.x * NW) {
    const bfu* yr = y1 + (size_t)t * 1024;
    f32x4 v[4];
    float s = 0.f;
#pragma unroll
    for (int i = 0; i < 4; ++i) { const u32x2 yw = *(const u32x2*)(yr + 4 * lane + 256 * i); v[i] = f32x4{bflo(yw[0]), bfhi(yw[0]), bflo(yw[1]), bfhi(yw[1])}; s += v[i][0] + v[i][1] + v[i][2] + v[i][3]; }
    const float mu = wave_sum(s) * (1.f / 1024.f);
    float q = 0.f;
#pragma unroll
    for (int i = 0; i < 4; ++i)
#pragma unroll
      for (int k = 0; k < 4; ++k) { const float d = v[i][k] - mu; q += d * d; }
    const float rstd = rsqrtf(wave_sum(q) * (1.f / 1024.f) + LN_EPS);
#pragma unroll
    for (int i = 0; i < 4; ++i) {
      f32x4 o;
#pragma unroll
      for (int k = 0; k < 4; ++k) o[k] = (v[i][k] - mu) * rstd * g[i][k] + b[i][k];
      u32x2 ob = {pk2(o[0], o[1]), pk2(o[2], o[3])};
      *(u32x2*)(x1b + (size_t)t * 1024 + 4 * lane + 256 * i) = ob;
    }
  }
  const size_t gtid = (size_t)blockIdx.x * NT + tid, gstride = (size_t)gridDim.x * NT;
  unsigned char* ub = (unsigned char*)(p.ws + OFF_UB); unsigned char* vb = (unsigned char*)(p.ws + OFF_VB);
  for (size_t i = gtid; i < (size_t)16384 * 1024 / 32; i += gstride) {
    u32x4 ou, ov;
#pragma unroll
    for (int k = 0; k < 4; ++k) {
      const f32x4 a0 = *(const f32x4*)(p.pu + i * 32 + 8 * k), a1 = *(const f32x4*)(p.pu + i * 32 + 8 * k + 4);
      const f32x4 c0 = *(const f32x4*)(p.pv + i * 32 + 8 * k), c1 = *(const f32x4*)(p.pv + i * 32 + 8 * k + 4);
      unsigned wu = 0, wv = 0;
      wu = __builtin_amdgcn_cvt_scalef32_pk_fp4_f32(wu, a0[0] * U_SCALE, a0[1] * U_SCALE, 1.0f, 0);
      wu = __builtin_amdgcn_cvt_scalef32_pk_fp4_f32(wu, a0[2] * U_SCALE, a0[3] * U_SCALE, 1.0f, 1);
      wu = __builtin_amdgcn_cvt_scalef32_pk_fp4_f32(wu, a1[0] * U_SCALE, a1[1] * U_SCALE, 1.0f, 2);
      wu = __builtin_amdgcn_cvt_scalef32_pk_fp4_f32(wu, a1[2] * U_SCALE, a1[3] * U_SCALE, 1.0f, 3);
      wv = __builtin_amdgcn_cvt_scalef32_pk_fp4_f32(wv, c0[0] * V_SCALE, c0[1] * V_SCALE, 1.0f, 0);
      wv = __builtin_amdgcn_cvt_scalef32_pk_fp4_f32(wv, c0[2] * V_SCALE, c0[3] * V_SCALE, 1.0f, 1);
      wv = __builtin_amdgcn_cvt_scalef32_pk_fp4_f32(wv, c1[0] * V_SCALE, c1[1] * V_SCALE, 1.0f, 2);
      wv = __builtin_amdgcn_cvt_scalef32_pk_fp4_f32(wv, c1[2] * V_SCALE, c1[3] * V_SCALE, 1.0f, 3);
      ou[k] = wu; ov[k] = wv;
    }
    const size_t e = i >> 5, c0 = (i & 31) * 32, dst = (c0 >> 8) * ((size_t)16384 * 128) + e * 128 + ((c0 & 255) >> 1);
    *(u32x4*)(ub + dst) = ou; *(u32x4*)(vb + dst) = ov;
  }
}

DI void phase6(const Params& p, char* smem) {
  const bfu* wt = (const bfu*)(p.ws + OFF_WQ);
  const bfu* x1b = (const bfu*)(p.ws + OFF_X1B);
  bfu* qp = (bfu*)(p.ws + OFF_QP);
  const int lane = opaque_tid() & 63, l31 = lane & 31, hf = lane >> 5;
  for (int idx = blockIdx.x; idx < 256 * 8; idx += gridDim.x) {
    int mt, nt; tile_map(idx, 8, mt, nt);
    const int m0 = mt * 256, n0 = nt * 256;
    gemm_tile<false>(x1b + (size_t)m0 * 1024, 1024, wt + (size_t)n0 * 1024, 1024, 1024, 256, smem,
      [&](int rl, int cl, const f32x4& v, bool) {
        *(u32x2*)(qp + (size_t)(m0 + rl) * 2048 + n0 + cl) = u32x2{pk2(v[0], v[1]), pk2(v[2], v[3])};
      });
  }
}

DI unsigned fsort(float f) { const unsigned u = __float_as_uint(f); return u ^ ((unsigned)((int)u >> 31) | 0x80000000u); }
DI float funsort(unsigned k) { return __uint_as_float(k ^ ((~(unsigned)((int)k >> 31)) | 0x80000000u)); }
#define CE(i, j) { const unsigned hi_ = a[i] > a[j] ? a[i] : a[j], lo_ = a[i] > a[j] ? a[j] : a[i]; a[i] = hi_; a[j] = lo_; }
DI void sort16(unsigned (&a)[16]) {
  CE(0,1) CE(2,3) CE(0,2) CE(1,3) CE(1,2) CE(4,5) CE(6,7) CE(4,6) CE(5,7) CE(5,6) CE(0,4) CE(2,6) CE(2,4) CE(1,5) CE(3,7) CE(3,5) CE(1,2) CE(3,4) CE(5,6) CE(8,9) CE(10,11) CE(8,10) CE(9,11) CE(9,10) CE(12,13) CE(14,15) CE(12,14) CE(13,15) CE(13,14) CE(8,12) CE(10,14) CE(10,12) CE(9,13) CE(11,15) CE(11,13) CE(9,10) CE(11,12) CE(13,14) CE(0,8) CE(4,12) CE(4,8) CE(2,10) CE(6,14) CE(6,10) CE(2,4) CE(6,8) CE(10,12) CE(1,9) CE(5,13) CE(5,9) CE(3,11) CE(7,15) CE(7,11) CE(3,5) CE(7,9) CE(11,13) CE(1,2) CE(3,4) CE(5,6) CE(7,8) CE(9,10) CE(11,12) CE(13,14)
}
DI void merge16(unsigned (&a)[16], const unsigned (&b)[16]) {
#pragma unroll
  for (int i = 0; i < 16; ++i) a[i] = a[i] > b[15 - i] ? a[i] : b[15 - i];
#pragma unroll
  for (int d = 8; d >= 1; d >>= 1)
#pragma unroll
    for (int i = 0; i < 16; ++i)
      if ((i & d) == 0) CE(i, i + d)
}
#undef CE
DI void topk_item(const Params& p, int mt, int h, char* smem) {
  const int tid = opaque_tid(), lane = tid & 63, w = tid >> 6, l31 = lane & 31, hf = lane >> 5;
  const int m0 = mt * 256;
  const bfu* qp = (const bfu*)(p.ws + OFF_QP);
  char* Qs = smem; char* Ks = smem + 69632;
  unsigned char* IL = (unsigned char*)(smem + 104448) + w * 1024 + l31 * 32;
  unsigned L[2][16];
#pragma unroll
  for (int j = 0; j < 2; ++j) {
    const bfu* kj = (const bfu*)(p.ws + (j ? OFF_K2 : OFF_K1)) + (size_t)h * 128 * 128;
    __syncthreads();
#pragma unroll
    for (int i = 0; i < 8; ++i) {
      const int c = tid + NT * i, row = c >> 4, part = c & 15;
      *(u32x4*)(Qs + row * 272 + part * 16) = *(const u32x4*)(qp + (size_t)(m0 + row) * 2048 + h * 256 + j * 128 + part * 8);
      if (i < 4) *(u32x4*)(Ks + row * 272 + part * 16) = *(const u32x4*)(kj + row * 128 + part * 8);
    }
    __syncthreads();
    f32x16 acc[4];
#pragma unroll
    for (int rt = 0; rt < 4; ++rt)
#pragma unroll
      for (int r = 0; r < 16; ++r) acc[rt][r] = 0.f;
#pragma unroll
    for (int ks = 0; ks < 8; ++ks) {
      const bf16x8 b = *(const bf16x8*)(Qs + (32 * w + l31) * 272 + (2 * ks + hf) * 16);
#pragma unroll
      for (int rt = 0; rt < 4; ++rt) {
        const bf16x8 a = *(const bf16x8*)(Ks + (rt * 32 + l31) * 272 + (2 * ks + hf) * 16);
        acc[rt] = mfma32(a, b, acc[rt]);
      }
    }
    unsigned g1[16], g2[16], g3[16];
#pragma unroll
    for (int r = 0; r < 16; ++r) {
      L[j][r] = (fsort(acc[0][r]) & ~0x7Fu) | (unsigned)(0 * 32 + crow(r, hf));
      g1[r] = (fsort(acc[1][r]) & ~0x7Fu) | (unsigned)(1 * 32 + crow(r, hf));
      g2[r] = (fsort(acc[2][r]) & ~0x7Fu) | (unsigned)(2 * 32 + crow(r, hf));
      g3[r] = (fsort(acc[3][r]) & ~0x7Fu) | (unsigned)(3 * 32 + crow(r, hf));
    }
    sort16(L[j]); sort16(g1); sort16(g2); sort16(g3);
    merge16(L[j], g1); merge16(g2, g3); merge16(L[j], g2);
    unsigned O[16];
#pragma unroll
    for (int i = 0; i < 16; ++i) O[i] = (unsigned)__shfl_xor((int)L[j][i], 32);
    merge16(L[j], O);
  }
  if (hf == 0) {
#pragma unroll
    for (int a = 0; a < 16; ++a) { IL[a] = (unsigned char)(L[0][a] & 0x7Fu); IL[16 + a] = (unsigned char)(L[1][a] & 0x7Fu); }
  }
  __syncthreads();
  float v1[16], v2[16];
#pragma unroll
  for (int a = 0; a < 16; ++a) { v1[a] = funsort(L[0][a] & ~0x7Fu); v2[a] = funsort(L[1][a] & ~0x7Fu); }
  unsigned C[16], c1[16], c2[16], c3[16];
#define CK(a, b) ((fsort(v1[a] + v2[b]) & ~0xFFu) | (unsigned)((a) * 16 + (b)))
#pragma unroll
  for (int b = 0; b < 16; ++b) C[b] = CK(0, b);
#pragma unroll
  for (int b = 0; b < 8; ++b) c1[b] = CK(1, b);
#pragma unroll
  for (int b = 0; b < 5; ++b) c1[8 + b] = CK(2, b);
  c1[13] = 0u; c1[14] = 0u; c1[15] = 0u;
#pragma unroll
  for (int b = 0; b < 4; ++b) c2[b] = CK(3, b);
#pragma unroll
  for (int b = 0; b < 3; ++b) c2[4 + b] = CK(4, b);
#pragma unroll
  for (int b = 0; b < 2; ++b) { c2[7 + b] = CK(5, b); c2[9 + b] = CK(6, b); c2[11 + b] = CK(7, b); }
  c2[13] = 0u; c2[14] = 0u; c2[15] = 0u;
#pragma unroll
  for (int a = 0; a < 8; ++a) { c3[a] = CK(8 + a, 0); c3[8 + a] = 0u; }
#undef CK
  sort16(C); sort16(c1); sort16(c2); sort16(c3);
  merge16(C, c1); merge16(c2, c3); merge16(C, c2);
  const float mx = funsort(C[0] & ~0xFFu);
  float e[16], sum = 0.f;
#pragma unroll
  for (int i = 0; i < 16; ++i) { e[i] = __expf(funsort(C[i] & ~0xFFu) - mx); sum += e[i]; }
  const float inv = 1.f / sum;
  const int t = m0 + 32 * w + l31;
  const size_t ob = ((size_t)t * 8 + h) * 16;
  if (hf == 0) {
    bfu* eo = (bfu*)(p.ws + OFF_EIDX) + ob;
#pragma unroll
    for (int i8 = 0; i8 < 2; ++i8) {
      u32x4 ev;
#pragma unroll
      for (int k = 0; k < 4; ++k) {
        const unsigned c0 = C[8 * i8 + 2 * k], c1 = C[8 * i8 + 2 * k + 1];
        const unsigned e0 = (unsigned)IL[(c0 >> 4) & 15] * 128u + (unsigned)IL[16 + (c0 & 15)], e1 = (unsigned)IL[(c1 >> 4) & 15] * 128u + (unsigned)IL[16 + (c1 & 15)];
        ev[k] = e0 | (e1 << 16);
      }
      *(u32x4*)(eo + 8 * i8) = ev;
    }
  } else {
    bfu* go = (bfu*)(p.ws + OFF_GW) + ob;
#pragma unroll
    for (int i8 = 0; i8 < 2; ++i8) {
      u32x4 gv;
#pragma unroll
      for (int k = 0; k < 4; ++k) gv[k] = pk2(e[8 * i8 + 2 * k] * inv, e[8 * i8 + 2 * k + 1] * inv);
      *(u32x4*)(go + 8 * i8) = gv;
    }
  }
}

DI void phase7(const Params& p, char* smem) {
  for (int i = blockIdx.x; i < 2048; i += gridDim.x) topk_item(p, i >> 3, i & 7, smem);
}

DI void phase8a(const Params& p) {
  const int tid = opaque_tid(), lane = tid & 63, w = tid >> 6, r = lane & 7, jg = lane >> 3;
  const int s = blockIdx.x & 3, par = (blockIdx.x >> 2) & 1, nvw = (gridDim.x >> 3) * NW, vw = (blockIdx.x >> 3) * NW + w;
  const unsigned char* u4 = (const unsigned char*)(p.ws + OFF_UB) + (size_t)s * (16384 * 128) + 16 * r;
  const bfu* eidx = (const bfu*)(p.ws + OFF_EIDX);
  bfu* part = (bfu*)(p.ws + OFF_PART) + (size_t)s * T * 128;
  const int b2 = (lane >> 2) & 1, b1 = (lane >> 1) & 1, b0 = lane & 1;
  const bfu* x1b = (const bfu*)(p.ws + OFF_X1B);
  constexpr int TH = T / 2;
  u32x4 xA[4], xB[4]; u32x4 eA[2], eB[2]; u32x4 dA[16], dB[16];
  auto load1 = [&](int j, u32x4 (&xq)[4], u32x4 (&ev)[2]) {
    j = j < TH ? j : TH - 1;
    const int t = 2 * j + par;
    const bfu* xr = x1b + (size_t)t * 1024 + 256 * s + 32 * r;
#pragma unroll
    for (int k = 0; k < 4; ++k) xq[k] = *(const u32x4*)(xr + 8 * k);
    ev[0] = *(const u32x4*)(eidx + (size_t)t * 128 + jg * 16); ev[1] = *(const u32x4*)(eidx + (size_t)t * 128 + jg * 16 + 8);
  };
  auto load2 = [&](const u32x4 (&ev)[2], u32x4 (&d)[16]) {
#pragma unroll
    for (int i = 0; i < 16; ++i) d[i] = *(const u32x4*)(u4 + (size_t)((ev[i >> 3][(i >> 1) & 3] >> (16 * (i & 1))) & 16383u) * 128);
  };
  auto comp = [&](int j, const u32x4 (&xq)[4], const u32x4 (&d)[16]) {
    const int t = 2 * j + par;
    f32x2 xx[16];
#pragma unroll
    for (int k = 0; k < 4; ++k)
#pragma unroll
      for (int b = 0; b < 4; ++b) { const unsigned w0 = xq[k][b]; xx[4 * k + b] = f32x2{bflo(w0), bfhi(w0)}; }
    float pr[16];
#pragma unroll
    for (int i = 0; i < 16; ++i) {
      f32x2 a2 = {0.f, 0.f};
#pragma unroll
      for (int k = 0; k < 4; ++k) {
        a2 += __builtin_amdgcn_cvt_scalef32_pk_f32_fp4(d[i][k], 1.0f, 0) * xx[4 * k + 0];
        a2 += __builtin_amdgcn_cvt_scalef32_pk_f32_fp4(d[i][k], 1.0f, 1) * xx[4 * k + 1];
        a2 += __builtin_amdgcn_cvt_scalef32_pk_f32_fp4(d[i][k], 1.0f, 2) * xx[4 * k + 2];
        a2 += __builtin_amdgcn_cvt_scalef32_pk_f32_fp4(d[i][k], 1.0f, 3) * xx[4 * k + 3];
      }
      pr[i] = a2[0] + a2[1];
    }
    float q8[8], q4[4], q2[2];
#pragma unroll
    for (int k = 0; k < 8; ++k) q8[k] = (b2 ? pr[8 + k] : pr[k]) + __shfl_xor(b2 ? pr[k] : pr[8 + k], 4);
#pragma unroll
    for (int k = 0; k < 4; ++k) q4[k] = (b1 ? q8[4 + k] : q8[k]) + __shfl_xor(b1 ? q8[k] : q8[4 + k], 2);
#pragma unroll
    for (int k = 0; k < 2; ++k) q2[k] = (b0 ? q4[2 + k] : q4[k]) + __shfl_xor(b0 ? q4[k] : q4[2 + k], 1);
    *(unsigned*)(part + (size_t)t * 128 + 2 * lane) = pk2(q2[0], q2[1]);
  };
  if ((int)(blockIdx.x >> 3) < (int)(gridDim.x >> 3)) {
    load1(vw, xA, eA); load2(eA, dA); load1(vw + nvw, xB, eB);
    for (int j = vw; j < TH; j += 2 * nvw) {
      load2(eB, dB);
      comp(j, xA, dA);
      load1(j + 2 * nvw, xA, eA);
      if (j + nvw < TH) {
        load2(eA, dA);
        comp(j + nvw, xB, dB);
        load1(j + 3 * nvw, xB, eB);
      }
    }
  }
}
DI void phase8b(const Params& p) {
  const int tid = opaque_tid(), lane = tid & 63, w = tid >> 6;
  const bfu* part = (const bfu*)(p.ws + OFF_PART);
  bfu* gw = (bfu*)(p.ws + OFF_GW);
  for (int t = blockIdx.x * NW + w; t < T; t += gridDim.x * NW) {
    f32x2 a = {0.f, 0.f};
#pragma unroll
    for (int s = 0; s < 4; ++s) { const unsigned pw = *(const unsigned*)(part + ((size_t)s * T + t) * 128 + 2 * lane); a += f32x2{bflo(pw), bfhi(pw)}; }
    a *= (1.f / U_SCALE);
    const unsigned gq = *(const unsigned*)(gw + (size_t)t * 128 + 2 * lane);
    const f32x2 g = {bflo(gq), bfhi(gq)};
    f32x2 c;
    c[0] = g[0] * 0.5f * a[0] * (1.f + erff(a[0] * 0.7071067811865476f)) * (1.f / V_SCALE);
    c[1] = g[1] * 0.5f * a[1] * (1.f + erff(a[1] * 0.7071067811865476f)) * (1.f / V_SCALE);
    *(unsigned*)(gw + (size_t)t * 128 + 2 * lane) = pk2(c[0], c[1]);
  }
}
DI void phase8c(const Params& p) {
  const int tid = opaque_tid(), lane = tid & 63, w = tid >> 6, r = lane & 7, jg = lane >> 3;
  const int s = blockIdx.x & 3, par = (blockIdx.x >> 2) & 1, nvw = (gridDim.x >> 3) * NW, vw = (blockIdx.x >> 3) * NW + w;
  const unsigned char* v4 = (const unsigned char*)(p.ws + OFF_VB) + (size_t)s * (16384 * 128) + 16 * r;
  const bfu* eidx = (const bfu*)(p.ws + OFF_EIDX);
  const bfu* gw = (const bfu*)(p.ws + OFF_GW);
  const int b5 = lane >> 5, b4 = (lane >> 4) & 1, b3 = (lane >> 3) & 1;
  constexpr int TH = T / 2;
  u32x4 cA[2], cB[2]; u32x4 eA[2], eB[2]; u32x4 dA[16], dB[16];
  auto load1 = [&](int j, u32x4 (&cv)[2], u32x4 (&ev)[2]) {
    j = j < TH ? j : TH - 1;
    const int t = 2 * j + par;
#pragma unroll
    for (int k = 0; k < 2; ++k) { cv[k] = *(const u32x4*)(gw + (size_t)t * 128 + jg * 16 + 8 * k); ev[k] = *(const u32x4*)(eidx + (size_t)t * 128 + jg * 16 + 8 * k); }
  };
  auto load2 = [&](const u32x4 (&ev)[2], u32x4 (&d)[16]) {
#pragma unroll
    for (int i = 0; i < 16; ++i) d[i] = *(const u32x4*)(v4 + (size_t)((ev[i >> 3][(i >> 1) & 3] >> (16 * (i & 1))) & 16383u) * 128);
  };
  auto comp = [&](int j, const u32x4 (&cv)[2], const u32x4 (&d)[16]) {
    const int t = 2 * j + par;
    const int col = 256 * s + 32 * r + 16 * b5 + 8 * b4 + 4 * b3;
    float* o = p.out + (size_t)t * 1024 + col;
    const u32x2 xw = *(const u32x2*)((const bfu*)(p.ws + OFF_X1B) + (size_t)t * 1024 + col);
    f32x2 acc[16];
#pragma unroll
    for (int k = 0; k < 16; ++k) acc[k] = f32x2{0.f, 0.f};
#pragma unroll
    for (int i = 0; i < 16; ++i) {
      const unsigned cw = cv[i >> 3][(i >> 1) & 3];
      const float ci = (i & 1) ? bfhi(cw) : bflo(cw);
      const f32x2 c2 = {ci, ci};
#pragma unroll
      for (int k = 0; k < 4; ++k) {
        acc[4 * k + 0] += c2 * __builtin_amdgcn_cvt_scalef32_pk_f32_fp4(d[i][k], 1.0f, 0);
        acc[4 * k + 1] += c2 * __builtin_amdgcn_cvt_scalef32_pk_f32_fp4(d[i][k], 1.0f, 1);
        acc[4 * k + 2] += c2 * __builtin_amdgcn_cvt_scalef32_pk_f32_fp4(d[i][k], 1.0f, 2);
        acc[4 * k + 3] += c2 * __builtin_amdgcn_cvt_scalef32_pk_f32_fp4(d[i][k], 1.0f, 3);
      }
    }
    float v[32], q16[16], q8[8], q4[4];
#pragma unroll
    for (int k = 0; k < 16; ++k) { v[2 * k] = acc[k][0]; v[2 * k + 1] = acc[k][1]; }
#pragma unroll
    for (int k = 0; k < 16; ++k) q16[k] = (b5 ? v[16 + k] : v[k]) + __shfl_xor(b5 ? v[k] : v[16 + k], 32);
#pragma unroll
    for (int k = 0; k < 8; ++k) q8[k] = (b4 ? q16[8 + k] : q16[k]) + __shfl_xor(b4 ? q16[k] : q16[8 + k], 16);
#pragma unroll
    for (int k = 0; k < 4; ++k) q4[k] = (b3 ? q8[4 + k] : q8[k]) + __shfl_xor(b3 ? q8[k] : q8[4 + k], 8);
    *(f32x4*)o = f32x4{ALPHA * bflo(xw[0]) + q4[0], ALPHA * bfhi(xw[0]) + q4[1], ALPHA * bflo(xw[1]) + q4[2], ALPHA * bfhi(xw[1]) + q4[3]};
  };
  if ((int)(blockIdx.x >> 3) < (int)(gridDim.x >> 3)) {
    load1(vw, cA, eA); load2(eA, dA); load1(vw + nvw, cB, eB);
    for (int j = vw; j < TH; j += 2 * nvw) {
      load2(eB, dB);
      comp(j, cA, dA);
      load1(j + 2 * nvw, cA, eA);
      if (j + nvw < TH) {
        load2(eA, dA);
        comp(j + nvw, cB, dB);
        load1(j + 3 * nvw, cB, eB);
      }
    }
  }
}
DI void phase8d(const Params& p) {
  const int tid = opaque_tid(), lane = tid & 63, w = tid >> 6;
  f32x4 g[4], b[4];
#pragma unroll
  for (int i = 0; i < 4; ++i) { g[i] = *(const f32x4*)(p.ln2g + 4 * lane + 256 * i); b[i] = *(const f32x4*)(p.ln2b + 4 * lane + 256 * i); }
  for (int t = blockIdx.x * NW + w; t < T; t += gridDim.x * NW) {
    float* yr = p.out + (size_t)t * 1024;
    f32x4 v[4];
    float s = 0.f;
#pragma unroll
    for (int i = 0; i < 4; ++i) { v[i] = *(const f32x4*)(yr + 4 * lane + 256 * i); s += v[i][0] + v[i][1] + v[i][2] + v[i][3]; }
    const float mu = wave_sum(s) * (1.f / 1024.f);
    float q = 0.f;
#pragma unroll
    for (int i = 0; i < 4; ++i)
#pragma unroll
      for (int k = 0; k < 4; ++k) { const float d = v[i][k] - mu; q += d * d; }
    const float rstd = rsqrtf(wave_sum(q) * (1.f / 1024.f) + LN_EPS);
#pragma unroll
    for (int i = 0; i < 4; ++i) {
      f32x4 o;
#pragma unroll
      for (int k = 0; k < 4; ++k) o[k] = (v[i][k] - mu) * rstd * g[i][k] + b[i][k];
      *(f32x4*)(yr + 4 * lane + 256 * i) = o;
    }
  }
}

DI void grid_barrier(unsigned* ctr, unsigned& target) {
  asm volatile("s_waitcnt vmcnt(0)" ::: "memory");
  __syncthreads();
  if (threadIdx.x == 0) {
    __builtin_amdgcn_fence(__ATOMIC_RELEASE, "agent");
    asm volatile("s_waitcnt vmcnt(0)" ::: "memory");
    target += gridDim.x;
    __hip_atomic_fetch_add(ctr, 1u, __ATOMIC_RELAXED, __HIP_MEMORY_SCOPE_AGENT);
    while (__hip_atomic_load(ctr, __ATOMIC_RELAXED, __HIP_MEMORY_SCOPE_AGENT) < target) __builtin_amdgcn_s_sleep(2);
    __builtin_amdgcn_fence(__ATOMIC_ACQUIRE, "agent");
    asm volatile("s_waitcnt vmcnt(0)" ::: "memory");
  }
  __syncthreads();
}

template <int PH>
__global__ void __launch_bounds__(512) mega(Params p) {
  extern __shared__ __attribute__((aligned(16))) char smem[];
  cg::grid_group grid = cg::this_grid();
  unsigned* bar = (unsigned*)(p.ws + OFF_BAR);
  unsigned bar_target = 0;
  if (PH < 0 || PH == 0) phase0(p, smem);
  if (PH < 0) grid.sync();
  if (PH < 0 || PH == 1) phase1(p, smem);
  if (PH < 0) grid_barrier(bar, bar_target);
  if (PH < 0 || PH == 2) phase2(p, smem);
  if (PH < 0) grid_barrier(bar, bar_target);
  if (PH < 0 || PH == 3) phase3(p, smem);
  if (PH < 0) grid_barrier(bar, bar_target);
  if (PH < 0 || PH == 4) phase4(p, smem);
  if (PH < 0) grid_barrier(bar, bar_target);
  if (PH < 0 || PH == 5) phase5(p);
  if (PH < 0) grid_barrier(bar, bar_target);
  if (PH < 0 || PH == 6) phase6(p, smem);
  if (PH < 0) grid_barrier(bar, bar_target);
  if (PH < 0 || PH == 7) phase7(p, smem);
  if (PH < 0) grid_barrier(bar, bar_target);
  if (PH < 0 || PH == 8) phase8a(p);
  if (PH < 0) grid_barrier(bar, bar_target);
  if (PH < 0 || PH == 9) phase8b(p);
  if (PH < 0) grid_barrier(bar, bar_target);
  if (PH < 0 || PH == 10) phase8c(p);
  if (PH < 0) grid_barrier(bar, bar_target);
  if (PH < 0 || PH == 11) phase8d(p);
}

template <int PH>
static void launch_phase(const Params& p, int grid, hipStream_t stream) {
  hipFuncSetAttribute((const void*)mega<PH>, hipFuncAttributeMaxDynamicSharedMemorySize, SMEM_BYTES);
  hipLaunchKernelGGL(mega<PH>, dim3(grid), dim3(NT), SMEM_BYTES, stream, p);
}

extern "C" void kernel_launch(void* const* d_in, const int* in_sizes, int n_in, void* d_out, int out_size, void* d_ws, size_t ws_size, hipStream_t stream) {
  static int grid_blocks = 0;
  if (!grid_blocks) {
    int dev = 0, cus = 0, per_cu = 0;
    hipGetDevice(&dev);
    hipDeviceGetAttribute(&cus, hipDeviceAttributeMultiprocessorCount, dev);
    hipFuncSetAttribute((const void*)mega<-1>, hipFuncAttributeMaxDynamicSharedMemorySize, SMEM_BYTES);
    hipOccupancyMaxActiveBlocksPerMultiprocessor(&per_cu, (const void*)mega<-1>, NT, SMEM_BYTES);
    if (per_cu < 1) per_cu = 1;
    if (per_cu > 1) per_cu = 1;
    grid_blocks = cus * per_cu;
    fprintf(stderr, "kernel_launch: cus %d per_cu %d grid %d ws %zu\n", cus, per_cu, grid_blocks, ws_size);
  }
  Params p{};
  p.xp = (const float*)d_in[0]; p.xs = (const float*)d_in[1]; p.w_in = (const float*)d_in[2]; p.conv_w = (const float*)d_in[3];
  p.qng = (const float*)d_in[4]; p.w_uq = (const float*)d_in[5]; p.kvng = (const float*)d_in[6]; p.w_ukv = (const float*)d_in[7];
  p.w_o = (const float*)d_in[8]; p.ln1g = (const float*)d_in[9]; p.ln1b = (const float*)d_in[10]; p.pwq = (const float*)d_in[11];
  p.pk1 = (const float*)d_in[12]; p.pk2 = (const float*)d_in[13]; p.pu = (const float*)d_in[14]; p.pv = (const float*)d_in[15];
  p.ln2g = (const float*)d_in[16]; p.ln2b = (const float*)d_in[17];
  p.out = (float*)d_out; p.ws = (char*)d_ws;
  for (int i = 0; i < 16; ++i) p.inv_freq[i] = 1.0 / pow(10000.0, (double)(2 * i) / 32.0);
#if MULTI_LAUNCH
  launch_phase<0>(p, grid_blocks, stream); launch_phase<1>(p, grid_blocks, stream); launch_phase<2>(p, grid_blocks, stream);
  launch_phase<3>(p, grid_blocks, stream); launch_phase<4>(p, grid_blocks, stream); launch_phase<5>(p, grid_blocks, stream);
  launch_phase<6>(p, grid_blocks, stream); launch_phase<7>(p, grid_blocks, stream); launch_phase<8>(p, grid_blocks, stream); launch_phase<9>(p, grid_blocks, stream); launch_phase<10>(p, grid_blocks, stream); launch_phase<11>(p, grid_blocks, stream);
#else
  (void)hipMemsetAsync((char*)d_ws + OFF_BAR, 0, 256, stream);
  void* args[] = {&p};
  hipError_t e = hipLaunchCooperativeKernel((const void*)mega<-1>, dim3(grid_blocks), dim3(NT), args, SMEM_BYTES, stream);
  if (e != hipSuccess) fprintf(stderr, "cooperative launch failed: %s (grid %d)\n", hipGetErrorString(e), grid_blocks);
#endif
}
```

```cpp
#include <hip/hip_runtime.h>
#include <hip/hip_cooperative_groups.h>
#include <cstdio>
#include <cmath>
namespace cg = cooperative_groups;

#define DI __device__ __forceinline__
typedef __attribute__((ext_vector_type(8))) short bf16x8;
typedef __attribute__((ext_vector_type(16))) float f32x16;
typedef __attribute__((ext_vector_type(4))) float f32x4;
typedef __attribute__((ext_vector_type(2))) float f32x2;
typedef __attribute__((ext_vector_type(4))) unsigned u32x4;
typedef __attribute__((ext_vector_type(2))) unsigned u32x2;
typedef __attribute__((ext_vector_type(4))) int i32x4;
typedef __attribute__((ext_vector_type(2))) __bf16 bf16x2_t;
typedef unsigned short bfu;
typedef __attribute__((ext_vector_type(8))) int i32x8;

#ifndef MULTI_LAUNCH
#define MULTI_LAUNCH 0
#endif

constexpr int T = 65536;
constexpr int TPROMPT = 32768;
constexpr int INC = 1952;
constexpr float ALPHA = 1.189207115002721f;
constexpr float LN_EPS = 1e-5f;
constexpr float RMS_EPS = 1e-6f;
constexpr size_t MiB = 1ull << 20;
constexpr size_t OFF_WIN = 0;
constexpr size_t OFF_WO = 4 * MiB;
constexpr size_t OFF_WQ = 6 * MiB;
constexpr size_t OFF_WUQ = 10 * MiB;
constexpr size_t OFF_WUKV = 10 * MiB + 512 * 1024;
constexpr size_t OFF_K1 = 10 * MiB + 768 * 1024;
constexpr size_t OFF_K2 = 11 * MiB;
constexpr size_t OFF_ROPE = 11 * MiB + 256 * 1024;
constexpr size_t OFF_BAR = 13 * MiB + 512 * 1024;
constexpr size_t OFF_Z = 14 * MiB;
constexpr size_t OFF_XB = 258 * MiB;
constexpr size_t OFF_QH = 258 * MiB;
constexpr size_t OFF_KH = 354 * MiB;
constexpr size_t OFF_Y1 = 14 * MiB;
constexpr size_t OFF_X1B = 270 * MiB;
constexpr size_t OFF_UB = 398 * MiB;
constexpr size_t OFF_VB = 414 * MiB;
constexpr size_t OFF_PART = 14 * MiB;
constexpr float U_SCALE = 54.f, V_SCALE = 8.f;
constexpr size_t OFF_QP = 14 * MiB;
constexpr size_t OFF_EIDX = 430 * MiB;
constexpr size_t OFF_GW = 462 * MiB;
constexpr size_t OUT_OFF_VT = 128 * MiB;

constexpr int GP = 144;
constexpr int NT = 512, NW = 8;
constexpr int GBUF = 256 * 128;
constexpr int EP = 68;
constexpr int SMEM_RS = 8 * 64 * EP * 4;
constexpr int SMEM_BYTES = SMEM_RS + 1024;

struct Params {
  const float* xp; const float* xs; const float* w_in; const float* conv_w; const float* qng; const float* w_uq;
  const float* kvng; const float* w_ukv; const float* w_o; const float* ln1g; const float* ln1b; const float* pwq;
  const float* pk1; const float* pk2; const float* pu; const float* pv; const float* ln2g; const float* ln2b;
  float* out; char* ws;
  double inv_freq[16];
};

DI int opaque_tid() { int t = threadIdx.x; asm volatile("" : "+v"(t)); return t; }
DI unsigned pk2(float a, float b) { f32x2 v = {a, b}; bf16x2_t r = __builtin_convertvector(v, bf16x2_t); return __builtin_bit_cast(unsigned, r); }
DI bfu f2bf(float a) { return (bfu)(pk2(a, 0.f) & 0xffffu); }
DI float bflo(unsigned w) { return __uint_as_float(w << 16); }
DI float bfhi(unsigned w) { return __uint_as_float(w & 0xffff0000u); }
DI unsigned pk4_fp8(float a, float b, float c, float d) { int w = __builtin_amdgcn_cvt_pk_fp8_f32(a, b, 0, false); w = __builtin_amdgcn_cvt_pk_fp8_f32(c, d, w, true); return (unsigned)w; }
DI float bf2f(bfu h) { return __uint_as_float(((unsigned)h) << 16); }
DI f32x16 mfma32(bf16x8 a, bf16x8 b, f32x16 c) { return __builtin_amdgcn_mfma_f32_32x32x16_bf16(a, b, c, 0, 0, 0); }
DI int crow(int i, int hf) { return (i & 3) + 8 * (i >> 2) + 4 * hf; }
DI float wave_sum(float v) {
#pragma unroll
  for (int o = 32; o >= 1; o >>= 1) v += __shfl_xor(v, o);
  return v;
}
DI void tok_geom(int t, int& seq_start, int& pos, int& S) {
  if (t < TPROMPT) { S = 16384; seq_start = t & ~16383; pos = t & 16383; }
  else { S = 4096; seq_start = t & ~4095; pos = t & 4095; }
}
DI const float* xrow(const Params& p, int t) { return t < TPROMPT ? p.xp + (size_t)t * 1024 : p.xs + (size_t)(t - TPROMPT) * 1024; }

DI void transpose_cvt(const float* __restrict__ src, bfu* __restrict__ dst, int K, int N, const float* __restrict__ gain, float scal, float* tile) {
  const int tn = N / 32, ntile = (K / 32) * tn;
  const int tq = opaque_tid(), tx = tq & 31, ty = tq >> 5;
  for (int tl = blockIdx.x; tl < ntile; tl += gridDim.x) {
    const int k0 = (tl / tn) * 32, n0 = (tl % tn) * 32;
    __syncthreads();
    for (int i = ty; i < 32; i += 16) { float g = gain ? gain[k0 + i] : 1.f; tile[i * 33 + tx] = src[(size_t)(k0 + i) * N + n0 + tx] * g * scal; }
    __syncthreads();
    for (int i = ty; i < 32; i += 16) dst[(size_t)(n0 + i) * K + k0 + tx] = f2bf(tile[tx * 33 + i]);
  }
}

DI void phase0(const Params& p, char* smem) {
  float* tile = (float*)smem;
  const float qscale = 0.10206207261596575f * 1.4426950408889634f;
  transpose_cvt(p.w_in, (bfu*)(p.ws + OFF_WIN), 1024, 1952, nullptr, 1.f, tile);
  transpose_cvt(p.w_o, (bfu*)(p.ws + OFF_WO), 1024, 1024, nullptr, 1.f, tile);
  transpose_cvt(p.pwq, (bfu*)(p.ws + OFF_WQ), 1024, 2048, nullptr, 1.f, tile);
  transpose_cvt(p.w_uq, (bfu*)(p.ws + OFF_WUQ), 256, 768, p.qng, qscale, tile);
  transpose_cvt(p.w_ukv, (bfu*)(p.ws + OFF_WUKV), 128, 1024, p.kvng, 1.f, tile);
  const int gtid = blockIdx.x * NT + opaque_tid(), gstride = gridDim.x * NT;
  bfu* k1b = (bfu*)(p.ws + OFF_K1); bfu* k2b = (bfu*)(p.ws + OFF_K2);
  for (int i = gtid; i < 8 * 128 * 128; i += gstride) { k1b[i] = f2bf(p.pk1[i]); k2b[i] = f2bf(p.pk2[i]); }
  bfu* xb = (bfu*)(p.ws + OFF_XB);
  for (int i = gtid; i < T * 128; i += gstride) {
    const float* src = xrow(p, i >> 7) + (i & 127) * 8;
    const f32x4 a = *(const f32x4*)src, b = *(const f32x4*)(src + 4);
    *(u32x4*)(xb + (size_t)i * 8) = u32x4{pk2(a[0], a[1]), pk2(a[2], a[3]), pk2(b[0], b[1]), pk2(b[2], b[3])};
  }
  f32x2* rope = (f32x2*)(p.ws + OFF_ROPE);
  for (int i = gtid; i < 16384 * 16; i += gstride) {
    const int pos = i >> 4, f = i & 15;
    double rev = (double)pos * p.inv_freq[f] * 0.15915494309189535;
    rev -= __builtin_rint(rev);
    const float fr = (float)rev;
    f32x2 cs = {__builtin_amdgcn_cosf(fr), __builtin_amdgcn_sinf(fr)};
    rope[i] = cs;
  }
}

DI void dma16(const void* src, char* lds_wave_base) { __builtin_amdgcn_global_load_lds((const unsigned*)src, (__attribute__((address_space(3))) unsigned*)lds_wave_base, 16, 0, 0); }
template <bool TRW1, class Epi>
DI void gemm_tile(const bfu* __restrict__ A, int lda, const bfu* __restrict__ Bt, int ldb, int K, int nrowsB, char* smem, Epi epi) {
  const int tid = opaque_tid(), lane = tid & 63, w = tid >> 6, wm = w >> 2, wn = w & 3;
  const int l31 = lane & 31, hf = lane >> 5;
  f32x16 acc[4][2];
#pragma unroll
  for (int i = 0; i < 4; ++i)
#pragma unroll
    for (int j = 0; j < 2; ++j)
#pragma unroll
      for (int r = 0; r < 16; ++r) acc[i][j][r] = 0.f;
  const int srow = lane >> 3, spos = lane & 7;
  const bfu* ap[4]; const bfu* bp[4];
#pragma unroll
  for (int i = 0; i < 4; ++i) {
    const int r = 8 * (w * 4 + i) + srow, c = spos ^ srow ^ (i & 1);
    ap[i] = A + (size_t)r * lda + c * 8;
    const int rB = r < nrowsB ? r : nrowsB - 1;
    bp[i] = Bt + (size_t)rB * ldb + c * 8;
  }
  auto stage = [&](int k0, int buf) {
#pragma unroll
    for (int i = 0; i < 4; ++i) {
      dma16(ap[i] + k0, smem + buf * GBUF + (w * 4 + i) * 1024);
      dma16(bp[i] + k0, smem + (2 + buf) * GBUF + (w * 4 + i) * 1024);
    }
  };
  const int nk = K / 64;
  const int xr = (l31 & 7) ^ ((l31 >> 3) & 1);
  __syncthreads();
  stage(0, 0);
  asm volatile("s_waitcnt vmcnt(0)" ::: "memory");
  __syncthreads();
#pragma unroll 1
  for (int kt = 0; kt < nk; ++kt) {
    if (kt + 1 < nk) stage((kt + 1) * 64, (kt + 1) & 1);
    const char* As = smem + (kt & 1) * GBUF + (wm * 128 + l31) * 128;
    const char* Bs = smem + (2 + (kt & 1)) * GBUF + (wn * 64 + l31) * 128;
#pragma unroll
    for (int s = 0; s < 4; ++s) {
      const int co = ((2 * s + hf) ^ xr) * 16;
      bf16x8 a[4], b[2];
#pragma unroll
      for (int i = 0; i < 4; ++i) a[i] = *(const bf16x8*)(As + i * 32 * 128 + co);
#pragma unroll
      for (int j = 0; j < 2; ++j) b[j] = *(const bf16x8*)(Bs + j * 32 * 128 + co);
#pragma unroll
      for (int i = 0; i < 4; ++i)
#pragma unroll
        for (int j = 0; j < 2; ++j) acc[i][j] = mfma32(a[i], b[j], acc[i][j]);
    }
    asm volatile("s_waitcnt vmcnt(0)" ::: "memory");
    __syncthreads();
  }
  float* st = (float*)(smem + w * (64 * EP * 4));
#pragma unroll
  for (int ps = 0; ps < 2; ++ps) {
    if (TRW1 && (wn & 1)) {
#pragma unroll
      for (int i = 0; i < 2; ++i)
#pragma unroll
        for (int j = 0; j < 2; ++j)
#pragma unroll
          for (int g = 0; g < 4; ++g)
            *(f32x4*)(st + (j * 32 + l31) * EP + i * 32 + 8 * g + 4 * hf) = f32x4{acc[2 * ps + i][j][4 * g], acc[2 * ps + i][j][4 * g + 1], acc[2 * ps + i][j][4 * g + 2], acc[2 * ps + i][j][4 * g + 3]};
#pragma unroll 8
      for (int it = 0; it < 16; ++it) {
        const int c = it * 4 + (lane >> 4), r4 = 4 * (lane & 15);
        const f32x4 v = *(const f32x4*)(st + c * EP + r4);
        epi(wm * 128 + ps * 64 + r4, wn * 64 + c, v, true);
      }
    } else {
#pragma unroll
      for (int i = 0; i < 2; ++i)
#pragma unroll
        for (int j = 0; j < 2; ++j)
#pragma unroll
          for (int r = 0; r < 16; ++r) st[(i * 32 + crow(r, hf)) * EP + j * 32 + l31] = acc[2 * ps + i][j][r];
#pragma unroll 8
      for (int it = 0; it < 16; ++it) {
        const int r = it * 4 + (lane >> 4), c4 = 4 * (lane & 15);
        const f32x4 v = *(const f32x4*)(st + r * EP + c4);
        epi(wm * 128 + ps * 64 + r, wn * 64 + c4, v, false);
      }
    }
  }
}

DI void tile_map(int idx, int NT, int& mt, int& nt) { const int x = idx & 7, j = idx >> 3; mt = (j / NT) * 8 + x; nt = j % NT; }

DI void phase1(const Params& p, char* smem) {
  const bfu* wt = (const bfu*)(p.ws + OFF_WIN);
  bfu* z = (bfu*)(p.ws + OFF_Z);
  const int lane = opaque_tid() & 63, l31 = lane & 31, hf = lane >> 5;
  for (int idx = blockIdx.x; idx < 256 * 8; idx += gridDim.x) {
    int mt, nt; tile_map(idx, 8, mt, nt);
    const int m0 = mt * 256, n0 = nt * 256;
    gemm_tile<false>((const bfu*)(p.ws + OFF_XB) + (size_t)m0 * 1024, 1024, wt + (size_t)n0 * 1024, 1024, 1024, INC - n0, smem,
      [&](int rl, int cl, const f32x4& v, bool) {
        if (n0 + cl < INC) *(u32x2*)(z + (size_t)(m0 + rl) * INC + n0 + cl) = u32x2{pk2(v[0], v[1]), pk2(v[2], v[3])};
      });
  }
}

DI void rms_rows(const bfu* zsrc, int width, float* rs) {
  const int tid = opaque_tid(), row = tid >> 1, half = tid & 1;
  const bfu* src = zsrc + (size_t)row * INC + half * (width / 2);
  float ss = 0.f;
  for (int c = 0; c < width / 2; c += 8) {
    const u32x4 v = *(const u32x4*)(src + c);
#pragma unroll
    for (int k = 0; k < 4; ++k) { const float a = bflo(v[k]), b = bfhi(v[k]); ss += a * a + b * b; }
  }
  ss += __shfl_xor(ss, 1);
  if (half == 0) rs[row] = rsqrtf(ss / (float)width + RMS_EPS);
}

DI void phase2(const Params& p, char* smem) {
  const bfu* z = (const bfu*)(p.ws + OFF_Z);
  bfu* mix = (bfu*)p.out;
  bfu* qh = (bfu*)(p.ws + OFF_QH);
  bfu* kh = (bfu*)(p.ws + OFF_KH);
  bfu* vT = (bfu*)((char*)p.out + OUT_OFF_VT);
  const f32x2* rope = (const f32x2*)(p.ws + OFF_ROPE);
  const int tid = opaque_tid(), lane = tid & 63, l31 = lane & 31, hf = lane >> 5;
  for (int it = blockIdx.x; it < T * 64 / NT; it += gridDim.x) {
    const int idx = it * NT + tid, t = idx >> 6, cc = (idx & 63) * 8;
    int ss, pos, S; tok_geom(t, ss, pos, S);
    const bfu* zr = z + (size_t)t * INC;
    const u32x4 bg = *(const u32x4*)(zr + cc);
    float y[8];
#pragma unroll
    for (int k = 0; k < 8; ++k) y[k] = 0.f;
#pragma unroll
    for (int dk = 0; dk < 3; ++dk) {
      const int pp = pos + dk - 1;
      if (pp >= 0 && pp < S) {
        const bfu* zn = zr + (ptrdiff_t)(dk - 1) * INC;
        const u32x4 cg_ = *(const u32x4*)(zn + 512 + cc), hg = *(const u32x4*)(zn + 1024 + cc);
        const f32x4 w0 = *(const f32x4*)(p.conv_w + dk * 512 + cc), w1 = *(const f32x4*)(p.conv_w + dk * 512 + cc + 4);
#pragma unroll
        for (int k = 0; k < 4; ++k) {
          const float wl = k < 2 ? w0[2 * k] : w1[2 * k - 4], wh = k < 2 ? w0[2 * k + 1] : w1[2 * k - 3];
          y[2 * k] += wl * bflo(cg_[k]) * bflo(hg[k]);
          y[2 * k + 1] += wh * bfhi(cg_[k]) * bfhi(hg[k]);
        }
      }
    }
    u32x4 o;
#pragma unroll
    for (int k = 0; k < 4; ++k) o[k] = pk2(bflo(bg[k]) * y[2 * k], bfhi(bg[k]) * y[2 * k + 1]);
    *(u32x4*)(mix + (size_t)t * 1024 + cc) = o;
  }
  for (int it = blockIdx.x; it < T * 16 / NT; it += gridDim.x) {
    const int idx = it * NT + tid, t = idx >> 4, f = idx & 15;
    int ss, pos, S; tok_geom(t, ss, pos, S);
    const float x1 = bf2f(z[(size_t)t * INC + 1920 + f]), x2 = bf2f(z[(size_t)t * INC + 1936 + f]);
    const f32x2 cs = rope[pos * 16 + f];
    const bfu o1 = f2bf(x1 * cs[0] - x2 * cs[1]), o2 = f2bf(x1 * cs[1] + x2 * cs[0]);
#pragma unroll
    for (int h = 0; h < 8; ++h) { bfu* d = kh + ((size_t)h * T + t) * 96 + 64 + f; d[0] = o1; d[16] = o2; }
  }
  float* rs = (float*)(smem + SMEM_RS);
  {
    const bfu* wt = (const bfu*)(p.ws + OFF_WUQ);
    for (int idx = blockIdx.x; idx < 256 * 3; idx += gridDim.x) {
      int mt, nt; tile_map(idx, 3, mt, nt);
      const int m0 = mt * 256, n0 = nt * 256;
      __syncthreads();
      rms_rows(z + (size_t)m0 * INC + 1536, 256, rs);
      gemm_tile<false>(z + (size_t)m0 * INC + 1536, INC, wt + (size_t)n0 * 256, 256, 256, 256, smem,
        [&](int rl, int cl, const f32x4& vin, bool) {
          const int col = n0 + cl, head = col / 96, d = col - head * 96, t = m0 + rl;
          const float sc = rs[rl];
          f32x4 v = vin * sc;
          f32x4 pr;
#pragma unroll
          for (int k = 0; k < 4; ++k) pr[k] = __shfl_xor(v[k], 4);
          if (d >= 64) {
            int ss, pos, S; tok_geom(t, ss, pos, S);
            const int f = (d - 64) & 15;
            const f32x4 cs0 = *(const f32x4*)(rope + pos * 16 + f), cs1 = *(const f32x4*)(rope + pos * 16 + f + 2);
            const float co[4] = {cs0[0], cs0[2], cs1[0], cs1[2]}, si[4] = {cs0[1], cs0[3], cs1[1], cs1[3]};
            const bool first = d < 80;
#pragma unroll
            for (int k = 0; k < 4; ++k) v[k] = first ? v[k] * co[k] - pr[k] * si[k] : pr[k] * si[k] + v[k] * co[k];
          }
          *(u32x2*)(qh + ((size_t)head * T + t) * 96 + d) = u32x2{pk2(v[0], v[1]), pk2(v[2], v[3])};
        });
    }
  }
  {
    const bfu* wt = (const bfu*)(p.ws + OFF_WUKV);
    for (int idx = blockIdx.x; idx < 256 * 4; idx += gridDim.x) {
      int mt, nt; tile_map(idx, 4, mt, nt);
      const int m0 = mt * 256, n0 = nt * 256;
      __syncthreads();
      rms_rows(z + (size_t)m0 * INC + 1792, 128, rs);
      gemm_tile<true>(z + (size_t)m0 * INC + 1792, INC, wt + (size_t)n0 * 128, 128, 128, 256, smem,
        [&](int rl, int cl, const f32x4& v, bool tr) {
          const int head = (n0 + cl) >> 7, dd = cl & 127;
          if (!tr) {
            const float sc = rs[rl];
            *(u32x2*)(kh + ((size_t)head * T + m0 + rl) * 96 + dd) = u32x2{pk2(v[0] * sc, v[1] * sc), pk2(v[2] * sc, v[3] * sc)};
          } else {
            const f32x4 sc = *(const f32x4*)(rs + rl);
            const int tk = m0 + rl, key = tk & 63;
            const int pos = 32 * ((key >> 3) & 1) + 16 * (key >> 5) + 8 * ((key >> 4) & 1) + (key & 7);
            *(unsigned*)((unsigned char*)vT + (((size_t)head * (T / 64) + (tk >> 6)) * 64 + (dd - 64)) * 64 + pos) = pk4_fp8(v[0] * sc[0], v[1] * sc[1], v[2] * sc[2], v[3] * sc[3]);
          }
        });
    }
  }
}

DI void attn_item64(const Params& p, int seq_start, int S, int h, int q0, char* smem) {
  const int tid = opaque_tid(), lane = tid & 63, w = tid >> 6, l31 = lane & 31, hf = lane >> 5;
  const bfu* qh = (const bfu*)(p.ws + OFF_QH);
  const bfu* kh = (const bfu*)(p.ws + OFF_KH);
  const bfu* vT = (const bfu*)((const char*)p.out + OUT_OFF_VT);
  constexpr int KP = 144, KB = 64 * KP, VB = 64 * 80;
  char* qsp = smem + 2 * KB + 2 * VB + w * 8192 + lane * 16;
  {
#pragma unroll
    for (int a = 0; a < 2; ++a) {
      const bfu* qrow = qh + ((size_t)h * T + q0 + 64 * w + 32 * a + l31) * 96 + 32 * hf;
#pragma unroll
      for (int kk = 0; kk < 2; ++kk) {
        const u32x4 r0 = *(const u32x4*)(qrow + 64 * kk), r1 = *(const u32x4*)(qrow + 64 * kk + 8), r2 = *(const u32x4*)(qrow + 64 * kk + 16), r3 = *(const u32x4*)(qrow + 64 * kk + 24);
        u32x4 lo = {pk4_fp8(bflo(r0[0]), bfhi(r0[0]), bflo(r0[1]), bfhi(r0[1])), pk4_fp8(bflo(r0[2]), bfhi(r0[2]), bflo(r0[3]), bfhi(r0[3])),
                    pk4_fp8(bflo(r1[0]), bfhi(r1[0]), bflo(r1[1]), bfhi(r1[1])), pk4_fp8(bflo(r1[2]), bfhi(r1[2]), bflo(r1[3]), bfhi(r1[3]))};
        u32x4 hi = {pk4_fp8(bflo(r2[0]), bfhi(r2[0]), bflo(r2[1]), bfhi(r2[1])), pk4_fp8(bflo(r2[2]), bfhi(r2[2]), bflo(r2[3]), bfhi(r2[3])),
                    pk4_fp8(bflo(r3[0]), bfhi(r3[0]), bflo(r3[1]), bfhi(r3[1])), pk4_fp8(bflo(r3[2]), bfhi(r3[2]), bflo(r3[3]), bfhi(r3[3]))};
        if (kk == 1 && hf == 1) { lo = u32x4{0u, 0u, 0u, 0u}; hi = u32x4{0u, 0u, 0u, 0u}; }
        *(u32x4*)(qsp + (a * 4 + kk * 2) * 1024) = lo; *(u32x4*)(qsp + (a * 4 + kk * 2 + 1) * 1024) = hi;
      }
    }
  }
  f32x16 o[2][2];
#pragma unroll
  for (int a = 0; a < 2; ++a)
#pragma unroll
    for (int d = 0; d < 2; ++d)
#pragma unroll
      for (int r = 0; r < 16; ++r) o[a][d][r] = 0.f;
  float m[2] = {0.f, 0.f}, lsum[2] = {0.f, 0.f};
  const char* kbase = (const char*)(kh + ((size_t)h * T + seq_start) * 96);
  const unsigned char* vbase = (const unsigned char*)vT + ((size_t)h * (T / 64) + (seq_start >> 6)) * 4096;
  u32x4 rk[2]; u32x2 rv;
  auto gload = [&](int kt) {
    const char* kp = kbase + (size_t)kt * 12288;
    rk[0] = *(const u32x4*)(kp + tid * 16);
    if (tid < 256) rk[1] = *(const u32x4*)(kp + (tid + NT) * 16);
    rv = *(const u32x2*)(vbase + (size_t)kt * 4096 + tid * 8);
  };
  auto swrite = [&](int buf) {
    { const int key = tid / 12, part = tid % 12; const u32x4 r = rk[0];
      *(u32x2*)(smem + buf * KB + key * KP + part * 8) = u32x2{pk4_fp8(bflo(r[0]), bfhi(r[0]), bflo(r[1]), bfhi(r[1])), pk4_fp8(bflo(r[2]), bfhi(r[2]), bflo(r[3]), bfhi(r[3]))}; }
    if (tid < 256) { const int c = tid + NT, key = c / 12, part = c % 12; const u32x4 r = rk[1];
      *(u32x2*)(smem + buf * KB + key * KP + part * 8) = u32x2{pk4_fp8(bflo(r[0]), bfhi(r[0]), bflo(r[1]), bfhi(r[1])), pk4_fp8(bflo(r[2]), bfhi(r[2]), bflo(r[3]), bfhi(r[3]))}; }
    { const int d = tid >> 3, part = tid & 7; *(u32x2*)(smem + 2 * KB + buf * VB + d * 80 + part * 8) = rv; }
  };
  const int prow = (l31 & 0x13) | ((l31 & 4) << 1) | ((l31 & 8) >> 1);
  const int nkt = S / 64;
  __syncthreads();
  if (tid < 128) {
    char* kp = smem + (tid >> 6) * KB + (tid & 63) * KP + 96;
    *(u32x4*)kp = u32x4{0x38u, 0u, 0u, 0u}; *(u32x4*)(kp + 16) = u32x4{0u, 0u, 0u, 0u};
  }
  gload(0); swrite(0);
  __syncthreads();
#pragma unroll 1
  for (int kt = 0; kt < nkt; ++kt) {
    if (kt + 1 < nkt) gload(kt + 1);
    const char* Ks = smem + (kt & 1) * KB + prow * KP + hf * 32;
    const char* Vs = smem + 2 * KB + (kt & 1) * VB + l31 * 80 + hf * 32;
    f32x16 s[2][2];
    {
      __builtin_amdgcn_s_setprio(1);
      f32x16 zz;
#pragma unroll
      for (int r = 0; r < 16; ++r) zz[r] = 0.f;
#pragma unroll
      for (int kk = 0; kk < 2; ++kk) {
        const u32x4 a0 = *(const u32x4*)(Ks + kk * 64), a1 = *(const u32x4*)(Ks + kk * 64 + 16);
        const u32x4 b0 = *(const u32x4*)(Ks + 32 * KP + kk * 64), b1 = *(const u32x4*)(Ks + 32 * KP + kk * 64 + 16);
        const i32x8 kA0 = {(int)a0[0], (int)a0[1], (int)a0[2], (int)a0[3], (int)a1[0], (int)a1[1], (int)a1[2], (int)a1[3]};
        const i32x8 kA1 = {(int)b0[0], (int)b0[1], (int)b0[2], (int)b0[3], (int)b1[0], (int)b1[1], (int)b1[2], (int)b1[3]};
#pragma unroll
        for (int a = 0; a < 2; ++a) {
          const u32x4 q0v = *(const u32x4*)(qsp + (a * 4 + kk * 2) * 1024), q1v = *(const u32x4*)(qsp + (a * 4 + kk * 2 + 1) * 1024);
          const i32x8 qB = {(int)q0v[0], (int)q0v[1], (int)q0v[2], (int)q0v[3], (int)q1v[0], (int)q1v[1], (int)q1v[2], (int)q1v[3]};
          s[a][0] = __builtin_amdgcn_mfma_scale_f32_32x32x64_f8f6f4(kA0, qB, kk == 0 ? zz : s[a][0], 0, 0, 0, 0x7F7F7F7F, 0, 0x7F7F7F7F);
          s[a][1] = __builtin_amdgcn_mfma_scale_f32_32x32x64_f8f6f4(kA1, qB, kk == 0 ? zz : s[a][1], 0, 0, 0, 0x7F7F7F7F, 0, 0x7F7F7F7F);
        }
      }
      __builtin_amdgcn_s_setprio(0);
    }
    float mx[2];
#pragma unroll
    for (int a = 0; a < 2; ++a) {
      float t = s[a][0][0];
#pragma unroll
      for (int r = 1; r < 16; ++r) t = fmaxf(t, s[a][0][r]);
#pragma unroll
      for (int r = 0; r < 16; ++r) t = fmaxf(t, s[a][1][r]);
      mx[a] = fmaxf(t, __shfl_xor(t, 32));
    }
    const bool need0 = (kt == 0) || (mx[0] > 8.f), need1 = (kt == 0) || (mx[1] > 8.f);
    if (__any(need0 || need1)) {
#pragma unroll
      for (int a = 0; a < 2; ++a) {
        const bool need = a ? need1 : need0;
        const float want = need ? (kt == 0 ? mx[a] : fmaxf(mx[a], 0.f)) : 0.f;
        const unsigned mb = pk4_fp8(m[a] + want, 0.f, 0.f, 0.f) & 0xffu;
        const float mnew = __builtin_amdgcn_cvt_pk_f32_fp8((int)mb, false)[0];
        const float delta = mnew - m[a];
        const float alpha = (kt == 0) ? 1.f : __builtin_amdgcn_exp2f(-delta);
        m[a] = mnew;
        lsum[a] *= alpha;
#pragma unroll
        for (int r = 0; r < 16; ++r) { o[a][0][r] *= alpha; o[a][1][r] *= alpha; s[a][0][r] -= delta; s[a][1][r] -= delta; }
        if (hf == 1) *(unsigned*)(qsp + (a * 4 + 2) * 1024) = mb ^ 0x80u;
      }
    }
#pragma unroll
    for (int a = 0; a < 2; ++a) {
      i32x8 pb;
      float ps = 0.f;
#pragma unroll
      for (int sub = 0; sub < 2; ++sub)
#pragma unroll
        for (int u = 0; u < 4; ++u) {
          const float e0 = __builtin_amdgcn_exp2f(s[a][sub][4 * u]), e1 = __builtin_amdgcn_exp2f(s[a][sub][4 * u + 1]);
          const float e2 = __builtin_amdgcn_exp2f(s[a][sub][4 * u + 2]), e3 = __builtin_amdgcn_exp2f(s[a][sub][4 * u + 3]);
          ps += (e0 + e1) + (e2 + e3);
          pb[4 * sub + u] = (int)pk4_fp8(e0, e1, e2, e3);
        }
      lsum[a] += ps;
#pragma unroll
      for (int dt = 0; dt < 2; ++dt) {
        const u32x4 lo = *(const u32x4*)(Vs + dt * 32 * 80), hi = *(const u32x4*)(Vs + dt * 32 * 80 + 16);
        const i32x8 va = {(int)lo[0], (int)lo[1], (int)lo[2], (int)lo[3], (int)hi[0], (int)hi[1], (int)hi[2], (int)hi[3]};
        o[a][dt] = __builtin_amdgcn_mfma_scale_f32_32x32x64_f8f6f4(va, pb, o[a][dt], 0, 0, 0, 0x7F7F7F7F, 0, 0x7F7F7F7F);
      }
    }
    if (kt + 1 < nkt) swrite((kt + 1) & 1);
    __syncthreads();
  }
  bfu* mix = (bfu*)p.out;
#pragma unroll
  for (int a = 0; a < 2; ++a) {
    const float lt = lsum[a] + __shfl_xor(lsum[a], 32);
    const float inv = 1.f / lt;
    const int t = q0 + 64 * w + 32 * a + l31;
#pragma unroll
    for (int g = 0; g < 4; ++g) {
      const int d = 8 * g + 4 * hf;
      u32x2 x0 = {pk2(o[a][0][4 * g] * inv, o[a][0][4 * g + 1] * inv), pk2(o[a][0][4 * g + 2] * inv, o[a][0][4 * g + 3] * inv)};
      u32x2 x1 = {pk2(o[a][1][4 * g] * inv, o[a][1][4 * g + 1] * inv), pk2(o[a][1][4 * g + 2] * inv, o[a][1][4 * g + 3] * inv)};
      *(u32x2*)(mix + (size_t)t * 1024 + 512 + h * 64 + d) = x0;
      *(u32x2*)(mix + (size_t)t * 1024 + 512 + h * 64 + 32 + d) = x1;
    }
  }
}

DI void phase3(const Params& p, char* smem) {
  for (int i = blockIdx.x; i < 1024; i += gridDim.x) {
    if (i < 512) { const int qb = i & 31, h = (i >> 5) & 7, sq = i >> 8; attn_item64(p, sq * 16384, 16384, h, sq * 16384 + qb * 512, smem); }
    else { const int j = i - 512, qb = j & 7, h = (j >> 3) & 7, sq = j >> 6; attn_item64(p, TPROMPT + sq * 4096, 4096, h, TPROMPT + sq * 4096 + qb * 512, smem); }
  }
}

DI void phase4(const Params& p, char* smem) {
  const bfu* wt = (const bfu*)(p.ws + OFF_WO);
  const bfu* mix = (const bfu*)p.out;
  bfu* y1 = (bfu*)(p.ws + OFF_Y1);
  const int lane = opaque_tid() & 63, l31 = lane & 31, hf = lane >> 5;
  for (int idx = blockIdx.x; idx < 256 * 4; idx += gridDim.x) {
    int mt, nt; tile_map(idx, 4, mt, nt);
    const int m0 = mt * 256, n0 = nt * 256;
    const float* xr = xrow(p, m0);
    gemm_tile<false>(mix + (size_t)m0 * 1024, 1024, wt + (size_t)n0 * 1024, 1024, 1024, 256, smem,
      [&](int rl, int cl, const f32x4& v, bool) {
        const f32x4 xv = *(const f32x4*)(xr + (size_t)rl * 1024 + n0 + cl);
        const f32x4 y = v + ALPHA * xv;
        *(u32x2*)(y1 + (size_t)(m0 + rl) * 1024 + n0 + cl) = u32x2{pk2(y[0], y[1]), pk2(y[2], y[3])};
      });
  }
}

DI void phase5(const Params& p) {
  const bfu* y1 = (const bfu*)(p.ws + OFF_Y1);
  bfu* x1b = (bfu*)(p.ws + OFF_X1B);
  const int tid = opaque_tid(), lane = tid & 63, w = tid >> 6;
  f32x4 g[4], b[4];
#pragma unroll
  for (int i = 0; i < 4; ++i) { g[i] = *(const f32x4*)(p.ln1g + 4 * lane + 256 * i); b[i] = *(const f32x4*)(p.ln1b + 4 * lane + 256 * i); }
  for (int t = blockIdx.x * NW + w; t < T; t += gridDim.x * NW) {
    const bfu* yr = y1 + (size_t)t * 1024;
    f32x4 v[4];
    float s = 0.f;
#pragma unroll
    for (int i = 0; i < 4; ++i) { const u32x2 yw = *(const u32x2*)(yr + 4 * lane + 256 * i); v[i] = f32x4{bflo(yw[0]), bfhi(yw[0]), bflo(yw[1]), bfhi(yw[1])}; s += v[i][0] + v[i][1] + v[i][2] + v[i][3]; }
    const float mu = wave_sum(s) * (1.f / 1024.f);
    float q = 0.f;
#pragma unroll
    for (int i = 0; i < 4; ++i)
#pragma unroll
      for (int k = 0; k < 4; ++k) { const float d = v[i][k] - mu; q += d * d; }
    const float rstd = rsqrtf(wave_sum(q) * (1.f / 1024.f) + LN_EPS);
#pragma unroll
    for (int i = 0; i < 4; ++i) {
      f32x4 o;
#pragma unroll
      for (int k = 0; k < 4; ++k) o[k] = (v[i][k] - mu) * rstd * g[i][k] + b[i][k];
      u32x2 ob = {pk2(o[0], o[1]), pk2(o[2], o[3])};
      *(u32x2*)(x1b + (size_t)t * 1024 + 4 * lane + 256 * i) = ob;
    }
  }
  const size_t gtid = (size_t)blockIdx.x * NT + tid, gstride = (size_t)gridDim.x * NT;
  unsigned char* ub = (unsigned char*)(p.ws + OFF_UB); unsigned char* vb = (unsigned char*)(p.ws + OFF_VB);
  for (size_t i = gtid; i < (size_t)16384 * 1024 / 32; i += gstride) {
    u32x4 ou, ov;
#pragma unroll
    for (int k = 0; k < 4; ++k) {
      const f32x4 a0 = *(const f32x4*)(p.pu + i * 32 + 8 * k), a1 = *(const f32x4*)(p.pu + i * 32 + 8 * k + 4);
      const f32x4 c0 = *(const f32x4*)(p.pv + i * 32 + 8 * k), c1 = *(const f32x4*)(p.pv + i * 32 + 8 * k + 4);
      unsigned wu = 0, wv = 0;
      wu = __builtin_amdgcn_cvt_scalef32_pk_fp4_f32(wu, a0[0] * U_SCALE, a0[1] * U_SCALE, 1.0f, 0);
      wu = __builtin_amdgcn_cvt_scalef32_pk_fp4_f32(wu, a0[2] * U_SCALE, a0[3] * U_SCALE, 1.0f, 1);
      wu = __builtin_amdgcn_cvt_scalef32_pk_fp4_f32(wu, a1[0] * U_SCALE, a1[1] * U_SCALE, 1.0f, 2);
      wu = __builtin_amdgcn_cvt_scalef32_pk_fp4_f32(wu, a1[2] * U_SCALE, a1[3] * U_SCALE, 1.0f, 3);
      wv = __builtin_amdgcn_cvt_scalef32_pk_fp4_f32(wv, c0[0] * V_SCALE, c0[1] * V_SCALE, 1.0f, 0);
      wv = __builtin_amdgcn_cvt_scalef32_pk_fp4_f32(wv, c0[2] * V_SCALE, c0[3] * V_SCALE, 1.0f, 1);
      wv = __builtin_amdgcn_cvt_scalef32_pk_fp4_f32(wv, c1[0] * V_SCALE, c1[1] * V_SCALE, 1.0f, 2);
      wv = __builtin_amdgcn_cvt_scalef32_pk_fp4_f32(wv, c1[2] * V_SCALE, c1[3] * V_SCALE, 1.0f, 3);
      ou[k] = wu; ov[k] = wv;
    }
    const size_t e = i >> 5, c0 = (i & 31) * 32, dst = (c0 >> 8) * ((size_t)16384 * 128) + e * 128 + ((c0 & 255) >> 1);
    *(u32x4*)(ub + dst) = ou; *(u32x4*)(vb + dst) = ov;
  }
}

DI void phase6(const Params& p, char* smem) {
  const bfu* wt = (const bfu*)(p.ws + OFF_WQ);
  const bfu* x1b = (const bfu*)(p.ws + OFF_X1B);
  bfu* qp = (bfu*)(p.ws + OFF_QP);
  const int lane = opaque_tid() & 63, l31 = lane & 31, hf = lane >> 5;
  for (int idx = blockIdx.x; idx < 256 * 8; idx += gridDim.x) {
    int mt, nt; tile_map(idx, 8, mt, nt);
    const int m0 = mt * 256, n0 = nt * 256;
    gemm_tile<false>(x1b + (size_t)m0 * 1024, 1024, wt + (size_t)n0 * 1024, 1024, 1024, 256, smem,
      [&](int rl, int cl, const f32x4& v, bool) {
        *(u32x2*)(qp + (size_t)(m0 + rl) * 2048 + n0 + cl) = u32x2{pk2(v[0], v[1]), pk2(v[2], v[3])};
      });
  }
}

DI unsigned fsort(float f) { const unsigned u = __float_as_uint(f); return u ^ ((unsigned)((int)u >> 31) | 0x80000000u); }
DI float funsort(unsigned k) { return __uint_as_float(k ^ ((~(unsigned)((int)k >> 31)) | 0x80000000u)); }
#define CE(i, j) { const unsigned hi_ = a[i] > a[j] ? a[i] : a[j], lo_ = a[i] > a[j] ? a[j] : a[i]; a[i] = hi_; a[j] = lo_; }
DI void sort16(unsigned (&a)[16]) {
  CE(0,1) CE(2,3) CE(0,2) CE(1,3) CE(1,2) CE(4,5) CE(6,7) CE(4,6) CE(5,7) CE(5,6) CE(0,4) CE(2,6) CE(2,4) CE(1,5) CE(3,7) CE(3,5) CE(1,2) CE(3,4) CE(5,6) CE(8,9) CE(10,11) CE(8,10) CE(9,11) CE(9,10) CE(12,13) CE(14,15) CE(12,14) CE(13,15) CE(13,14) CE(8,12) CE(10,14) CE(10,12) CE(9,13) CE(11,15) CE(11,13) CE(9,10) CE(11,12) CE(13,14) CE(0,8) CE(4,12) CE(4,8) CE(2,10) CE(6,14) CE(6,10) CE(2,4) CE(6,8) CE(10,12) CE(1,9) CE(5,13) CE(5,9) CE(3,11) CE(7,15) CE(7,11) CE(3,5) CE(7,9) CE(11,13) CE(1,2) CE(3,4) CE(5,6) CE(7,8) CE(9,10) CE(11,12) CE(13,14)
}
DI void merge16(unsigned (&a)[16], const unsigned (&b)[16]) {
#pragma unroll
  for (int i = 0; i < 16; ++i) a[i] = a[i] > b[15 - i] ? a[i] : b[15 - i];
#pragma unroll
  for (int d = 8; d >= 1; d >>= 1)
#pragma unroll
    for (int i = 0; i < 16; ++i)
      if ((i & d) == 0) CE(i, i + d)
}
#undef CE
DI void topk_item(const Params& p, int mt, int h, char* smem) {
  const int tid = opaque_tid(), lane = tid & 63, w = tid >> 6, l31 = lane & 31, hf = lane >> 5;
  const int m0 = mt * 256;
  const bfu* qp = (const bfu*)(p.ws + OFF_QP);
  char* Qs = smem; char* Ks = smem + 69632;
  unsigned char* IL = (unsigned char*)(smem + 104448) + w * 1024 + l31 * 32;
  unsigned L[2][16];
#pragma unroll
  for (int j = 0; j < 2; ++j) {
    const bfu* kj = (const bfu*)(p.ws + (j ? OFF_K2 : OFF_K1)) + (size_t)h * 128 * 128;
    __syncthreads();
#pragma unroll
    for (int i = 0; i < 8; ++i) {
      const int c = tid + NT * i, row = c >> 4, part = c & 15;
      *(u32x4*)(Qs + row * 272 + part * 16) = *(const u32x4*)(qp + (size_t)(m0 + row) * 2048 + h * 256 + j * 128 + part * 8);
      if (i < 4) *(u32x4*)(Ks + row * 272 + part * 16) = *(const u32x4*)(kj + row * 128 + part * 8);
    }
    __syncthreads();
    f32x16 acc[4];
#pragma unroll
    for (int rt = 0; rt < 4; ++rt)
#pragma unroll
      for (int r = 0; r < 16; ++r) acc[rt][r] = 0.f;
#pragma unroll
    for (int ks = 0; ks < 8; ++ks) {
      const bf16x8 b = *(const bf16x8*)(Qs + (32 * w + l31) * 272 + (2 * ks + hf) * 16);
#pragma unroll
      for (int rt = 0; rt < 4; ++rt) {
        const bf16x8 a = *(const bf16x8*)(Ks + (rt * 32 + l31) * 272 + (2 * ks + hf) * 16);
        acc[rt] = mfma32(a, b, acc[rt]);
      }
    }
    unsigned g1[16], g2[16], g3[16];
#pragma unroll
    for (int r = 0; r < 16; ++r) {
      L[j][r] = (fsort(acc[0][r]) & ~0x7Fu) | (unsigned)(0 * 32 + crow(r, hf));
      g1[r] = (fsort(acc[1][r]) & ~0x7Fu) | (unsigned)(1 * 32 + crow(r, hf));
      g2[r] = (fsort(acc[2][r]) & ~0x7Fu) | (unsigned)(2 * 32 + crow(r, hf));
      g3[r] = (fsort(acc[3][r]) & ~0x7Fu) | (unsigned)(3 * 32 + crow(r, hf));
    }
    sort16(L[j]); sort16(g1); sort16(g2); sort16(g3);
    merge16(L[j], g1); merge16(g2, g3); merge16(L[j], g2);
    unsigned O[16];
#pragma unroll
    for (int i = 0; i < 16; ++i) O[i] = (unsigned)__shfl_xor((int)L[j][i], 32);
    merge16(L[j], O);
  }
  if (hf == 0) {
#pragma unroll
    for (int a = 0; a < 16; ++a) { IL[a] = (unsigned char)(L[0][a] & 0x7Fu); IL[16 + a] = (unsigned char)(L[1][a] & 0x7Fu); }
  }
  __syncthreads();
  float v1[16], v2[16];
#pragma unroll
  for (int a = 0; a < 16; ++a) { v1[a] = funsort(L[0][a] & ~0x7Fu); v2[a] = funsort(L[1][a] & ~0x7Fu); }
  unsigned C[16], c1[16], c2[16], c3[16];
#define CK(a, b) ((fsort(v1[a] + v2[b]) & ~0xFFu) | (unsigned)((a) * 16 + (b)))
#pragma unroll
  for (int b = 0; b < 16; ++b) C[b] = CK(0, b);
#pragma unroll
  for (int b = 0; b < 8; ++b) c1[b] = CK(1, b);
#pragma unroll
  for (int b = 0; b < 5; ++b) c1[8 + b] = CK(2, b);
  c1[13] = 0u; c1[14] = 0u; c1[15] = 0u;
#pragma unroll
  for (int b = 0; b < 4; ++b) c2[b] = CK(3, b);
#pragma unroll
  for (int b = 0; b < 3; ++b) c2[4 + b] = CK(4, b);
#pragma unroll
  for (int b = 0; b < 2; ++b) { c2[7 + b] = CK(5, b); c2[9 + b] = CK(6, b); c2[11 + b] = CK(7, b); }
  c2[13] = 0u; c2[14] = 0u; c2[15] = 0u;
#pragma unroll
  for (int a = 0; a < 8; ++a) { c3[a] = CK(8 + a, 0); c3[8 + a] = 0u; }
#undef CK
  sort16(C); sort16(c1); sort16(c2); sort16(c3);
  merge16(C, c1); merge16(c2, c3); merge16(C, c2);
  const float mx = funsort(C[0] & ~0xFFu);
  float e[16], sum = 0.f;
#pragma unroll
  for (int i = 0; i < 16; ++i) { e[i] = __expf(funsort(C[i] & ~0xFFu) - mx); sum += e[i]; }
  const float inv = 1.f / sum;
  const int t = m0 + 32 * w + l31;
  const size_t ob = ((size_t)t * 8 + h) * 16;
  if (hf == 0) {
    bfu* eo = (bfu*)(p.ws + OFF_EIDX) + ob;
#pragma unroll
    for (int i8 = 0; i8 < 2; ++i8) {
      u32x4 ev;
#pragma unroll
      for (int k = 0; k < 4; ++k) {
        const unsigned c0 = C[8 * i8 + 2 * k], c1 = C[8 * i8 + 2 * k + 1];
        const unsigned e0 = (unsigned)IL[(c0 >> 4) & 15] * 128u + (unsigned)IL[16 + (c0 & 15)], e1 = (unsigned)IL[(c1 >> 4) & 15] * 128u + (unsigned)IL[16 + (c1 & 15)];
        ev[k] = e0 | (e1 << 16);
      }
      *(u32x4*)(eo + 8 * i8) = ev;
    }
  } else {
    bfu* go = (bfu*)(p.ws + OFF_GW) + ob;
#pragma unroll
    for (int i8 = 0; i8 < 2; ++i8) {
      u32x4 gv;
#pragma unroll
      for (int k = 0; k < 4; ++k) gv[k] = pk2(e[8 * i8 + 2 * k] * inv, e[8 * i8 + 2 * k + 1] * inv);
      *(u32x4*)(go + 8 * i8) = gv;
    }
  }
}

DI void phase7(const Params& p, char* smem) {
  for (int i = blockIdx.x; i < 2048; i += gridDim.x) topk_item(p, i >> 3, i & 7, smem);
}

DI void phase8a(const Params& p) {
  const int tid = opaque_tid(), lane = tid & 63, w = tid >> 6, r = lane & 7, jg = lane >> 3;
  const int s = blockIdx.x & 3, par = (blockIdx.x >> 2) & 1, nvw = (gridDim.x >> 3) * NW, vw = (blockIdx.x >> 3) * NW + w;
  const unsigned char* u4 = (const unsigned char*)(p.ws + OFF_UB) + (size_t)s * (16384 * 128) + 16 * r;
  const bfu* eidx = (const bfu*)(p.ws + OFF_EIDX);
  bfu* part = (bfu*)(p.ws + OFF_PART) + (size_t)s * T * 128;
  const int b2 = (lane >> 2) & 1, b1 = (lane >> 1) & 1, b0 = lane & 1;
  const bfu* x1b = (const bfu*)(p.ws + OFF_X1B);
  constexpr int TH = T / 2;
  u32x4 xA[4], xB[4]; u32x4 eA[2], eB[2]; u32x4 dA[16], dB[16];
  auto load1 = [&](int j, u32x4 (&xq)[4], u32x4 (&ev)[2]) {
    j = j < TH ? j : TH - 1;
    const int t = 2 * j + par;
    const bfu* xr = x1b + (size_t)t * 1024 + 256 * s + 32 * r;
#pragma unroll
    for (int k = 0; k < 4; ++k) xq[k] = *(const u32x4*)(xr + 8 * k);
    ev[0] = *(const u32x4*)(eidx + (size_t)t * 128 + jg * 16); ev[1] = *(const u32x4*)(eidx + (size_t)t * 128 + jg * 16 + 8);
  };
  auto load2 = [&](const u32x4 (&ev)[2], u32x4 (&d)[16]) {
#pragma unroll
    for (int i = 0; i < 16; ++i) d[i] = *(const u32x4*)(u4 + (size_t)((ev[i >> 3][(i >> 1) & 3] >> (16 * (i & 1))) & 16383u) * 128);
  };
  auto comp = [&](int j, const u32x4 (&xq)[4], const u32x4 (&d)[16]) {
    const int t = 2 * j + par;
    f32x2 xx[16];
#pragma unroll
    for (int k = 0; k < 4; ++k)
#pragma unroll
      for (int b = 0; b < 4; ++b) { const unsigned w0 = xq[k][b]; xx[4 * k + b] = f32x2{bflo(w0), bfhi(w0)}; }
    float pr[16];
#pragma unroll
    for (int i = 0; i < 16; ++i) {
      f32x2 a2 = {0.f, 0.f};
#pragma unroll
      for (int k = 0; k < 4; ++k) {
        a2 += __builtin_amdgcn_cvt_scalef32_pk_f32_fp4(d[i][k], 1.0f, 0) * xx[4 * k + 0];
        a2 += __builtin_amdgcn_cvt_scalef32_pk_f32_fp4(d[i][k], 1.0f, 1) * xx[4 * k + 1];
        a2 += __builtin_amdgcn_cvt_scalef32_pk_f32_fp4(d[i][k], 1.0f, 2) * xx[4 * k + 2];
        a2 += __builtin_amdgcn_cvt_scalef32_pk_f32_fp4(d[i][k], 1.0f, 3) * xx[4 * k + 3];
      }
      pr[i] = a2[0] + a2[1];
    }
    float q8[8], q4[4], q2[2];
#pragma unroll
    for (int k = 0; k < 8; ++k) q8[k] = (b2 ? pr[8 + k] : pr[k]) + __shfl_xor(b2 ? pr[k] : pr[8 + k], 4);
#pragma unroll
    for (int k = 0; k < 4; ++k) q4[k] = (b1 ? q8[4 + k] : q8[k]) + __shfl_xor(b1 ? q8[k] : q8[4 + k], 2);
#pragma unroll
    for (int k = 0; k < 2; ++k) q2[k] = (b0 ? q4[2 + k] : q4[k]) + __shfl_xor(b0 ? q4[k] : q4[2 + k], 1);
    *(unsigned*)(part + (size_t)t * 128 + 2 * lane) = pk2(q2[0], q2[1]);
  };
  if ((int)(blockIdx.x >> 3) < (int)(gridDim.x >> 3)) {
    load1(vw, xA, eA); load2(eA, dA); load1(vw + nvw, xB, eB);
    for (int j = vw; j < TH; j += 2 * nvw) {
      load2(eB, dB);
      comp(j, xA, dA);
      load1(j + 2 * nvw, xA, eA);
      if (j + nvw < TH) {
        load2(eA, dA);
        comp(j + nvw, xB, dB);
        load1(j + 3 * nvw, xB, eB);
      }
    }
  }
}
DI void phase8b(const Params& p) {
  const int tid = opaque_tid(), lane = tid & 63, w = tid >> 6;
  const bfu* part = (const bfu*)(p.ws + OFF_PART);
  bfu* gw = (bfu*)(p.ws + OFF_GW);
  for (int t = blockIdx.x * NW + w; t < T; t += gridDim.x * NW) {
    f32x2 a = {0.f, 0.f};
#pragma unroll
    for (int s = 0; s < 4; ++s) { const unsigned pw = *(const unsigned*)(part + ((size_t)s * T + t) * 128 + 2 * lane); a += f32x2{bflo(pw), bfhi(pw)}; }
    a *= (1.f / U_SCALE);
    const unsigned gq = *(const unsigned*)(gw + (size_t)t * 128 + 2 * lane);
    const f32x2 g = {bflo(gq), bfhi(gq)};
    f32x2 c;
    c[0] = g[0] * 0.5f * a[0] * (1.f + erff(a[0] * 0.7071067811865476f)) * (1.f / V_SCALE);
    c[1] = g[1] * 0.5f * a[1] * (1.f + erff(a[1] * 0.7071067811865476f)) * (1.f / V_SCALE);
    *(unsigned*)(gw + (size_t)t * 128 + 2 * lane) = pk2(c[0], c[1]);
  }
}
DI void phase8c(const Params& p) {
  const int tid = opaque_tid(), lane = tid & 63, w = tid >> 6, r = lane & 7, jg = lane >> 3;
  const int s = blockIdx.x & 3, par = (blockIdx.x >> 2) & 1, nvw = (gridDim.x >> 3) * NW, vw = (blockIdx.x >> 3) * NW + w;
  const unsigned char* v4 = (const unsigned char*)(p.ws + OFF_VB) + (size_t)s * (16384 * 128) + 16 * r;
  const bfu* eidx = (const bfu*)(p.ws + OFF_EIDX);
  const bfu* gw = (const bfu*)(p.ws + OFF_GW);
  const int b5 = lane >> 5, b4 = (lane >> 4) & 1, b3 = (lane >> 3) & 1;
  constexpr int TH = T / 2;
  u32x4 cA[2], cB[2]; u32x4 eA[2], eB[2]; u32x4 dA[16], dB[16];
  auto load1 = [&](int j, u32x4 (&cv)[2], u32x4 (&ev)[2]) {
    j = j < TH ? j : TH - 1;
    const int t = 2 * j + par;
#pragma unroll
    for (int k = 0; k < 2; ++k) { cv[k] = *(const u32x4*)(gw + (size_t)t * 128 + jg * 16 + 8 * k); ev[k] = *(const u32x4*)(eidx + (size_t)t * 128 + jg * 16 + 8 * k); }
  };
  auto load2 = [&](const u32x4 (&ev)[2], u32x4 (&d)[16]) {
#pragma unroll
    for (int i = 0; i < 16; ++i) d[i] = *(const u32x4*)(v4 + (size_t)((ev[i >> 3][(i >> 1) & 3] >> (16 * (i & 1))) & 16383u) * 128);
  };
  auto comp = [&](int j, const u32x4 (&cv)[2], const u32x4 (&d)[16]) {
    const int t = 2 * j + par;
    const int col = 256 * s + 32 * r + 16 * b5 + 8 * b4 + 4 * b3;
    float* o = p.out + (size_t)t * 1024 + col;
    const u32x2 xw = *(const u32x2*)((const bfu*)(p.ws + OFF_X1B) + (size_t)t * 1024 + col);
    f32x2 acc[16];
#pragma unroll
    for (int k = 0; k < 16; ++k) acc[k] = f32x2{0.f, 0.f};
#pragma unroll
    for (int i = 0; i < 16; ++i) {
      const unsigned cw = cv[i >> 3][(i >> 1) & 3];
      const float ci = (i & 1) ? bfhi(cw) : bflo(cw);
      const f32x2 c2 = {ci, ci};
#pragma unroll
      for (int k = 0; k < 4; ++k) {
        acc[4 * k + 0] += c2 * __builtin_amdgcn_cvt_scalef32_pk_f32_fp4(d[i][k], 1.0f, 0);
        acc[4 * k + 1] += c2 * __builtin_amdgcn_cvt_scalef32_pk_f32_fp4(d[i][k], 1.0f, 1);
        acc[4 * k + 2] += c2 * __builtin_amdgcn_cvt_scalef32_pk_f32_fp4(d[i][k], 1.0f, 2);
        acc[4 * k + 3] += c2 * __builtin_amdgcn_cvt_scalef32_pk_f32_fp4(d[i][k], 1.0f, 3);
      }
    }
    float v[32], q16[16], q8[8], q4[4];
#pragma unroll
    for (int k = 0; k < 16; ++k) { v[2 * k] = acc[k][0]; v[2 * k + 1] = acc[k][1]; }
#pragma unroll
    for (int k = 0; k < 16; ++k) q16[k] = (b5 ? v[16 + k] : v[k]) + __shfl_xor(b5 ? v[k] : v[16 + k], 32);
#pragma unroll
    for (int k = 0; k < 8; ++k) q8[k] = (b4 ? q16[8 + k] : q16[k]) + __shfl_xor(b4 ? q16[k] : q16[8 + k], 16);
#pragma unroll
    for (int k = 0; k < 4; ++k) q4[k] = (b3 ? q8[4 + k] : q8[k]) + __shfl_xor(b3 ? q8[k] : q8[4 + k], 8);
    *(f32x4*)o = f32x4{ALPHA * bflo(xw[0]) + q4[0], ALPHA * bfhi(xw[0]) + q4[1], ALPHA * bflo(xw[1]) + q4[2], ALPHA * bfhi(xw[1]) + q4[3]};
  };
  if ((int)(blockIdx.x >> 3) < (int)(gridDim.x >> 3)) {
    load1(vw, cA, eA); load2(eA, dA); load1(vw + nvw, cB, eB);
    for (int j = vw; j < TH; j += 2 * nvw) {
      load2(eB, dB);
      comp(j, cA, dA);
      load1(j + 2 * nvw, cA, eA);
      if (j + nvw < TH) {
        load2(eA, dA);
        comp(j + nvw, cB, dB);
        load1(j + 3 * nvw, cB, eB);
      }
    }
  }
}
DI void phase8d(const Params& p) {
  const int tid = opaque_tid(), lane = tid & 63, w = tid >> 6;
  f32x4 g[4], b[4];
#pragma unroll
  for (int i = 0; i < 4; ++i) { g[i] = *(const f32x4*)(p.ln2g + 4 * lane + 256 * i); b[i] = *(const f32x4*)(p.ln2b + 4 * lane + 256 * i); }
  for (int t = blockIdx.x * NW + w; t < T; t += gridDim.x * NW) {
    float* yr = p.out + (size_t)t * 1024;
    f32x4 v[4];
    float s = 0.f;
#pragma unroll
    for (int i = 0; i < 4; ++i) { v[i] = *(const f32x4*)(yr + 4 * lane + 256 * i); s += v[i][0] + v[i][1] + v[i][2] + v[i][3]; }
    const float mu = wave_sum(s) * (1.f / 1024.f);
    float q = 0.f;
#pragma unroll
    for (int i = 0; i < 4; ++i)
#pragma unroll
      for (int k = 0; k < 4; ++k) { const float d = v[i][k] - mu; q += d * d; }
    const float rstd = rsqrtf(wave_sum(q) * (1.f / 1024.f) + LN_EPS);
#pragma unroll
    for (int i = 0; i < 4; ++i) {
      f32x4 o;
#pragma unroll
      for (int k = 0; k < 4; ++k) o[k] = (v[i][k] - mu) * rstd * g[i][k] + b[i][k];
      *(f32x4*)(yr + 4 * lane + 256 * i) = o;
    }
  }
}

DI void grid_barrier(unsigned* ctr, unsigned& target) {
  asm volatile("s_waitcnt vmcnt(0)" ::: "memory");
  __syncthreads();
  if (threadIdx.x == 0) {
    __builtin_amdgcn_fence(__ATOMIC_RELEASE, "agent");
    asm volatile("s_waitcnt vmcnt(0)" ::: "memory");
    target += gridDim.x;
    __hip_atomic_fetch_add(ctr, 1u, __ATOMIC_RELAXED, __HIP_MEMORY_SCOPE_AGENT);
    while (__hip_atomic_load(ctr, __ATOMIC_RELAXED, __HIP_MEMORY_SCOPE_AGENT) < target) __builtin_amdgcn_s_sleep(2);
    __builtin_amdgcn_fence(__ATOMIC_ACQUIRE, "agent");
    asm volatile("s_waitcnt vmcnt(0)" ::: "memory");
  }
  __syncthreads();
}

template <int PH>
__global__ void __launch_bounds__(512) mega(Params p) {
  extern __shared__ __attribute__((aligned(16))) char smem[];
  cg::grid_group grid = cg::this_grid();
  unsigned* bar = (unsigned*)(p.ws + OFF_BAR);
  unsigned bar_target = 0;
  if (PH < 0 || PH == 0) phase0(p, smem);
  if (PH < 0) grid.sync();
  if (PH < 0 || PH == 1) phase1(p, smem);
  if (PH < 0) grid_barrier(bar, bar_target);
  if (PH < 0 || PH == 2) phase2(p, smem);
  if (PH < 0) grid_barrier(bar, bar_target);
  if (PH < 0 || PH == 3) phase3(p, smem);
  if (PH < 0) grid_barrier(bar, bar_target);
  if (PH < 0 || PH == 4) phase4(p, smem);
  if (PH < 0) grid_barrier(bar, bar_target);
  if (PH < 0 || PH == 5) phase5(p);
  if (PH < 0) grid_barrier(bar, bar_target);
  if (PH < 0 || PH == 6) phase6(p, smem);
  if (PH < 0) grid_barrier(bar, bar_target);
  if (PH < 0 || PH == 7) phase7(p, smem);
  if (PH < 0) grid_barrier(bar, bar_target);
  if (PH < 0 || PH == 8) phase8a(p);
  if (PH < 0) grid_barrier(bar, bar_target);
  if (PH < 0 || PH == 9) phase8b(p);
  if (PH < 0) grid_barrier(bar, bar_target);
  if (PH < 0 || PH == 10) phase8c(p);
  if (PH < 0) grid_barrier(bar, bar_target);
  if (PH < 0 || PH == 11) phase8d(p);
}

template <int PH>
static void launch_phase(const Params& p, int grid, hipStream_t stream) {
  hipFuncSetAttribute((const void*)mega<PH>, hipFuncAttributeMaxDynamicSharedMemorySize, SMEM_BYTES);
  hipLaunchKernelGGL(mega<PH>, dim3(grid), dim3(NT), SMEM_BYTES, stream, p);
}

extern "C" void kernel_launch(void* const* d_in, const int* in_sizes, int n_in, void* d_out, int out_size, void* d_ws, size_t ws_size, hipStream_t stream) {
  static int grid_blocks = 0;
  if (!grid_blocks) {
    int dev = 0, cus = 0, per_cu = 0;
    hipGetDevice(&dev);
    hipDeviceGetAttribute(&cus, hipDeviceAttributeMultiprocessorCount, dev);
    hipFuncSetAttribute((const void*)mega<-1>, hipFuncAttributeMaxDynamicSharedMemorySize, SMEM_BYTES);
    hipOccupancyMaxActiveBlocksPerMultiprocessor(&per_cu, (const void*)mega<-1>, NT, SMEM_BYTES);
    if (per_cu < 1) per_cu = 1;
    if (per_cu > 1) per_cu = 1;
    grid_blocks = cus * per_cu;
    fprintf(stderr, "kernel_launch: cus %d per_cu %d grid %d ws %zu\n", cus, per_cu, grid_blocks, ws_size);
  }
  Params p{};
  p.xp = (const float*)d_in[0]; p.xs = (const float*)d_in[1]; p.w_in = (const float*)d_in[2]; p.conv_w = (const float*)d_in[3];
  p.qng = (const float*)d_in[4]; p.w_uq = (const float*)d_in[5]; p.kvng = (const float*)d_in[6]; p.w_ukv = (const float*)d_in[7];
  p.w_o = (const float*)d_in[8]; p.ln1g = (const float*)d_in[9]; p.ln1b = (const float*)d_in[10]; p.pwq = (const float*)d_in[11];
  p.pk1 = (const float*)d_in[12]; p.pk2 = (const float*)d_in[13]; p.pu = (const float*)d_in[14]; p.pv = (const float*)d_in[15];
  p.ln2g = (const float*)d_in[16]; p.ln2b = (const float*)d_in[17];
  p.out = (float*)d_out; p.ws = (char*)d_ws;
  for (int i = 0; i < 16; ++i) p.inv_freq[i] = 1.0 / pow(10000.0, (double)(2 * i) / 32.0);
#if MULTI_LAUNCH
  launch_phase<0>(p, grid_blocks, stream); launch_phase<1>(p, grid_blocks, stream); launch_phase<2>(p, grid_blocks, stream);
  launch_phase<3>(p, grid_blocks, stream); launch_phase<4>(p, grid_blocks, stream); launch_phase<5>(p, grid_blocks, stream);
  launch_phase<6>(p, grid_blocks, stream); launch_phase<7>(p, grid_blocks, stream); launch_phase<8>(p, grid_blocks, stream); launch_phase<9>(p, grid_blocks, stream); launch_phase<10>(p, grid_blocks, stream); launch_phase<11>(p, grid_blocks, stream);
#else
  (void)hipMemsetAsync((char*)d_ws + OFF_BAR, 0, 256, stream);
  void* args[] = {&p};
  hipError_t e = hipLaunchCooperativeKernel((const void*)mega<-1>, dim3(grid_blocks), dim3(NT), args, SMEM_BYTES, stream);
  if (e != hipSuccess) fprintf(stderr, "cooperative launch failed: %s (grid %d)\n", hipGetErrorString(e), grid_blocks);
#endif
}
```

```cpp
#include <hip/hip_runtime.h>
#include <hip/hip_cooperative_groups.h>
#include <cstdio>
#include <cmath>
namespace cg = cooperative_groups;

#define DI __device__ __forceinline__
typedef __attribute__((ext_vector_type(8))) short bf16x8;
typedef __attribute__((ext_vector_type(16))) float f32x16;
typedef __attribute__((ext_vector_type(4))) float f32x4;
typedef __attribute__((ext_vector_type(2))) float f32x2;
typedef __attribute__((ext_vector_type(4))) unsigned u32x4;
typedef __attribute__((ext_vector_type(2))) unsigned u32x2;
typedef __attribute__((ext_vector_type(4))) int i32x4;
typedef __attribute__((ext_vector_type(2))) __bf16 bf16x2_t;
typedef unsigned short bfu;
typedef __attribute__((ext_vector_type(8))) int i32x8;

#ifndef MULTI_LAUNCH
#define MULTI_LAUNCH 0
#endif

constexpr int T = 65536;
constexpr int TPROMPT = 32768;
constexpr int INC = 1952;
constexpr float ALPHA = 1.189207115002721f;
constexpr float LN_EPS = 1e-5f;
constexpr float RMS_EPS = 1e-6f;
constexpr size_t MiB = 1ull << 20;
constexpr size_t OFF_WIN = 0;
constexpr size_t OFF_WO = 4 * MiB;
constexpr size_t OFF_WQ = 6 * MiB;
constexpr size_t OFF_WUQ = 10 * MiB;
constexpr size_t OFF_WUKV = 10 * MiB + 512 * 1024;
constexpr size_t OFF_K1 = 10 * MiB + 768 * 1024;
constexpr size_t OFF_K2 = 11 * MiB;
constexpr size_t OFF_ROPE = 11 * MiB + 256 * 1024;
constexpr size_t OFF_BAR = 13 * MiB + 512 * 1024;
constexpr size_t OFF_Z = 14 * MiB;
constexpr size_t OFF_XB = 258 * MiB;
constexpr size_t OFF_QH = 258 * MiB;
constexpr size_t OFF_KH = 354 * MiB;
constexpr size_t OFF_Y1 = 14 * MiB;
constexpr size_t OFF_X1B = 270 * MiB;
constexpr size_t OFF_UB = 398 * MiB;
constexpr size_t OFF_VB = 414 * MiB;
constexpr size_t OFF_PART = 14 * MiB;
constexpr float U_SCALE = 54.f, V_SCALE = 8.f;
constexpr size_t OFF_QP = 14 * MiB;
constexpr size_t OFF_EIDX = 430 * MiB;
constexpr size_t OFF_GW = 462 * MiB;
constexpr size_t OUT_OFF_VT = 128 * MiB;

constexpr int GP = 144;
constexpr int NT = 512, NW = 8;
constexpr int GBUF = 256 * 128;
constexpr int EP = 68;
constexpr int SMEM_RS = 8 * 64 * EP * 4;
constexpr int SMEM_BYTES = SMEM_RS + 1024;

struct Params {
  const float* xp; const float* xs; const float* w_in; const float* conv_w; const float* qng; const float* w_uq;
  const float* kvng; const float* w_ukv; const float* w_o; const float* ln1g; const float* ln1b; const float* pwq;
  const float* pk1; const float* pk2; const float* pu; const float* pv; const float* ln2g; const float* ln2b;
  float* out; char* ws;
  double inv_freq[16];
};

DI int opaque_tid() { int t = threadIdx.x; asm volatile("" : "+v"(t)); return t; }
DI unsigned pk2(float a, float b) { f32x2 v = {a, b}; bf16x2_t r = __builtin_convertvector(v, bf16x2_t); return __builtin_bit_cast(unsigned, r); }
DI bfu f2bf(float a) { return (bfu)(pk2(a, 0.f) & 0xffffu); }
DI float bflo(unsigned w) { return __uint_as_float(w << 16); }
DI float bfhi(unsigned w) { return __uint_as_float(w & 0xffff0000u); }
DI unsigned pk4_fp8(float a, float b, float c, float d) { int w = __builtin_amdgcn_cvt_pk_fp8_f32(a, b, 0, false); w = __builtin_amdgcn_cvt_pk_fp8_f32(c, d, w, true); return (unsigned)w; }
DI float bf2f(bfu h) { return __uint_as_float(((unsigned)h) << 16); }
DI f32x16 mfma32(bf16x8 a, bf16x8 b, f32x16 c) { return __builtin_amdgcn_mfma_f32_32x32x16_bf16(a, b, c, 0, 0, 0); }
DI int crow(int i, int hf) { return (i & 3) + 8 * (i >> 2) + 4 * hf; }
DI float wave_sum(float v) {
#pragma unroll
  for (int o = 32; o >= 1; o >>= 1) v += __shfl_xor(v, o);
  return v;
}
DI void tok_geom(int t, int& seq_start, int& pos, int& S) {
  if (t < TPROMPT) { S = 16384; seq_start = t & ~16383; pos = t & 16383; }
  else { S = 4096; seq_start = t & ~4095; pos = t & 4095; }
}
DI const float* xrow(const Params& p, int t) { return t < TPROMPT ? p.xp + (size_t)t * 1024 : p.xs + (size_t)(t - TPROMPT) * 1024; }

DI void transpose_cvt(const float* __restrict__ src, bfu* __restrict__ dst, int K, int N, const float* __restrict__ gain, float scal, float* tile) {
  const int tn = N / 32, ntile = (K / 32) * tn;
  const int tq = opaque_tid(), tx = tq & 31, ty = tq >> 5;
  for (int tl = blockIdx.x; tl < ntile; tl += gridDim.x) {
    const int k0 = (tl / tn) * 32, n0 = (tl % tn) * 32;
    __syncthreads();
    for (int i = ty; i < 32; i += 16) { float g = gain ? gain[k0 + i] : 1.f; tile[i * 33 + tx] = src[(size_t)(k0 + i) * N + n0 + tx] * g * scal; }
    __syncthreads();
    for (int i = ty; i < 32; i += 16) dst[(size_t)(n0 + i) * K + k0 + tx] = f2bf(tile[tx * 33 + i]);
  }
}

DI void phase0(const Params& p, char* smem) {
  float* tile = (float*)smem;
  const float qscale = 0.10206207261596575f * 1.4426950408889634f;
  transpose_cvt(p.w_in, (bfu*)(p.ws + OFF_WIN), 1024, 1952, nullptr, 1.f, tile);
  transpose_cvt(p.w_o, (bfu*)(p.ws + OFF_WO), 1024, 1024, nullptr, 1.f, tile);
  transpose_cvt(p.pwq, (bfu*)(p.ws + OFF_WQ), 1024, 2048, nullptr, 1.f, tile);
  transpose_cvt(p.w_uq, (bfu*)(p.ws + OFF_WUQ), 256, 768, p.qng, qscale, tile);
  transpose_cvt(p.w_ukv, (bfu*)(p.ws + OFF_WUKV), 128, 1024, p.kvng, 1.f, tile);
  const int gtid = blockIdx.x * NT + opaque_tid(), gstride = gridDim.x * NT;
  bfu* k1b = (bfu*)(p.ws + OFF_K1); bfu* k2b = (bfu*)(p.ws + OFF_K2);
  for (int i = gtid; i < 8 * 128 * 128; i += gstride) { k1b[i] = f2bf(p.pk1[i]); k2b[i] = f2bf(p.pk2[i]); }
  bfu* xb = (bfu*)(p.ws + OFF_XB);
  for (int i = gtid; i < T * 128; i += gstride) {
    const float* src = xrow(p, i >> 7) + (i & 127) * 8;
    const f32x4 a = *(const f32x4*)src, b = *(const f32x4*)(src + 4);
    *(u32x4*)(xb + (size_t)i * 8) = u32x4{pk2(a[0], a[1]), pk2(a[2], a[3]), pk2(b[0], b[1]), pk2(b[2], b[3])};
  }
  f32x2* rope = (f32x2*)(p.ws + OFF_ROPE);
  for (int i = gtid; i < 16384 * 16; i += gstride) {
    const int pos = i >> 4, f = i & 15;
    double rev = (double)pos * p.inv_freq[f] * 0.15915494309189535;
    rev -= __builtin_rint(rev);
    const float fr = (float)rev;
    f32x2 cs = {__builtin_amdgcn_cosf(fr), __builtin_amdgcn_sinf(fr)};
    rope[i] = cs;
  }
}

DI void dma16(const void* src, char* lds_wave_base) { __builtin_amdgcn_global_load_lds((const unsigned*)src, (__attribute__((address_space(3))) unsigned*)lds_wave_base, 16, 0, 0); }
template <bool TRW1, class Epi>
DI void gemm_tile(const bfu* __restrict__ A, int lda, const bfu* __restrict__ Bt, int ldb, int K, int nrowsB, char* smem, Epi epi) {
  const int tid = opaque_tid(), lane = tid & 63, w = tid >> 6, wm = w >> 2, wn = w & 3;
  const int l31 = lane & 31, hf = lane >> 5;
  f32x16 acc[4][2];
#pragma unroll
  for (int i = 0; i < 4; ++i)
#pragma unroll
    for (int j = 0; j < 2; ++j)
#pragma unroll
      for (int r = 0; r < 16; ++r) acc[i][j][r] = 0.f;
  const int srow = lane >> 3, spos = lane & 7;
  const bfu* ap[4]; const bfu* bp[4];
#pragma unroll
  for (int i = 0; i < 4; ++i) {
    const int r = 8 * (w * 4 + i) + srow, c = spos ^ srow ^ (i & 1);
    ap[i] = A + (size_t)r * lda + c * 8;
    const int rB = r < nrowsB ? r : nrowsB - 1;
    bp[i] = Bt + (size_t)rB * ldb + c * 8;
  }
  auto stage = [&](int k0, int buf) {
#pragma unroll
    for (int i = 0; i < 4; ++i) {
      dma16(ap[i] + k0, smem + buf * GBUF + (w * 4 + i) * 1024);
      dma16(bp[i] + k0, smem + (2 + buf) * GBUF + (w * 4 + i) * 1024);
    }
  };
  const int nk = K / 64;
  const int xr = (l31 & 7) ^ ((l31 >> 3) & 1);
  __syncthreads();
  stage(0, 0);
  asm volatile("s_waitcnt vmcnt(0)" ::: "memory");
  __syncthreads();
#pragma unroll 1
  for (int kt = 0; kt < nk; ++kt) {
    if (kt + 1 < nk) stage((kt + 1) * 64, (kt + 1) & 1);
    const char* As = smem + (kt & 1) * GBUF + (wm * 128 + l31) * 128;
    const char* Bs = smem + (2 + (kt & 1)) * GBUF + (wn * 64 + l31) * 128;
#pragma unroll
    for (int s = 0; s < 4; ++s) {
      const int co = ((2 * s + hf) ^ xr) * 16;
      bf16x8 a[4], b[2];
#pragma unroll
      for (int i = 0; i < 4; ++i) a[i] = *(const bf16x8*)(As + i * 32 * 128 + co);
#pragma unroll
      for (int j = 0; j < 2; ++j) b[j] = *(const bf16x8*)(Bs + j * 32 * 128 + co);
#pragma unroll
      for (int i = 0; i < 4; ++i)
#pragma unroll
        for (int j = 0; j < 2; ++j) acc[i][j] = mfma32(a[i], b[j], acc[i][j]);
    }
    asm volatile("s_waitcnt vmcnt(0)" ::: "memory");
    __syncthreads();
  }
  float* st = (float*)(smem + w * (64 * EP * 4));
#pragma unroll
  for (int ps = 0; ps < 2; ++ps) {
    if (TRW1 && (wn & 1)) {
#pragma unroll
      for (int i = 0; i < 2; ++i)
#pragma unroll
        for (int j = 0; j < 2; ++j)
#pragma unroll
          for (int g = 0; g < 4; ++g)
            *(f32x4*)(st + (j * 32 + l31) * EP + i * 32 + 8 * g + 4 * hf) = f32x4{acc[2 * ps + i][j][4 * g], acc[2 * ps + i][j][4 * g + 1], acc[2 * ps + i][j][4 * g + 2], acc[2 * ps + i][j][4 * g + 3]};
#pragma unroll 8
      for (int it = 0; it < 16; ++it) {
        const int c = it * 4 + (lane >> 4), r4 = 4 * (lane & 15);
        const f32x4 v = *(const f32x4*)(st + c * EP + r4);
        epi(wm * 128 + ps * 64 + r4, wn * 64 + c, v, true);
      }
    } else {
#pragma unroll
      for (int i = 0; i < 2; ++i)
#pragma unroll
        for (int j = 0; j < 2; ++j)
#pragma unroll
          for (int r = 0; r < 16; ++r) st[(i * 32 + crow(r, hf)) * EP + j * 32 + l31] = acc[2 * ps + i][j][r];
#pragma unroll 8
      for (int it = 0; it < 16; ++it) {
        const int r = it * 4 + (lane >> 4), c4 = 4 * (lane & 15);
        const f32x4 v = *(const f32x4*)(st + r * EP + c4);
        epi(wm * 128 + ps * 64 + r, wn * 64 + c4, v, false);
      }
    }
  }
}

DI void tile_map(int idx, int NT, int& mt, int& nt) { const int x = idx & 7, j = idx >> 3; mt = (j / NT) * 8 + x; nt = j % NT; }

DI void phase1(const Params& p, char* smem) {
  const bfu* wt = (const bfu*)(p.ws + OFF_WIN);
  bfu* z = (bfu*)(p.ws + OFF_Z);
  const int lane = opaque_tid() & 63, l31 = lane & 31, hf = lane >> 5;
  for (int idx = blockIdx.x; idx < 256 * 8; idx += gridDim.x) {
    int mt, nt; tile_map(idx, 8, mt, nt);
    const int m0 = mt * 256, n0 = nt * 256;
    gemm_tile<false>((const bfu*)(p.ws + OFF_XB) + (size_t)m0 * 1024, 1024, wt + (size_t)n0 * 1024, 1024, 1024, INC - n0, smem,
      [&](int rl, int cl, const f32x4& v, bool) {
        if (n0 + cl < INC) *(u32x2*)(z + (size_t)(m0 + rl) * INC + n0 + cl) = u32x2{pk2(v[0], v[1]), pk2(v[2], v[3])};
      });
  }
}

DI void rms_rows(const bfu* zsrc, int width, float* rs) {
  const int tid = opaque_tid(), row = tid >> 1, half = tid & 1;
  const bfu* src = zsrc + (size_t)row * INC + half * (width / 2);
  float ss = 0.f;
  for (int c = 0; c < width / 2; c += 8) {
    const u32x4 v = *(const u32x4*)(src + c);
#pragma unroll
    for (int k = 0; k < 4; ++k) { const float a = bflo(v[k]), b = bfhi(v[k]); ss += a * a + b * b; }
  }
  ss += __shfl_xor(ss, 1);
  if (half == 0) rs[row] = rsqrtf(ss / (float)width + RMS_EPS);
}

DI void phase2(const Params& p, char* smem) {
  const bfu* z = (const bfu*)(p.ws + OFF_Z);
  bfu* mix = (bfu*)p.out;
  bfu* qh = (bfu*)(p.ws + OFF_QH);
  bfu* kh = (bfu*)(p.ws + OFF_KH);
  bfu* vT = (bfu*)((char*)p.out + OUT_OFF_VT);
  const f32x2* rope = (const f32x2*)(p.ws + OFF_ROPE);
  const int tid = opaque_tid(), lane = tid & 63, l31 = lane & 31, hf = lane >> 5;
  for (int it = blockIdx.x; it < T * 64 / NT; it += gridDim.x) {
    const int idx = it * NT + tid, t = idx >> 6, cc = (idx & 63) * 8;
    int ss, pos, S; tok_geom(t, ss, pos, S);
    const bfu* zr = z + (size_t)t * INC;
    const u32x4 bg = *(const u32x4*)(zr + cc);
    float y[8];
#pragma unroll
    for (int k = 0; k < 8; ++k) y[k] = 0.f;
#pragma unroll
    for (int dk = 0; dk < 3; ++dk) {
      const int pp = pos + dk - 1;
      if (pp >= 0 && pp < S) {
        const bfu* zn = zr + (ptrdiff_t)(dk - 1) * INC;
        const u32x4 cg_ = *(const u32x4*)(zn + 512 + cc), hg = *(const u32x4*)(zn + 1024 + cc);
        const f32x4 w0 = *(const f32x4*)(p.conv_w + dk * 512 + cc), w1 = *(const f32x4*)(p.conv_w + dk * 512 + cc + 4);
#pragma unroll
        for (int k = 0; k < 4; ++k) {
          const float wl = k < 2 ? w0[2 * k] : w1[2 * k - 4], wh = k < 2 ? w0[2 * k + 1] : w1[2 * k - 3];
          y[2 * k] += wl * bflo(cg_[k]) * bflo(hg[k]);
          y[2 * k + 1] += wh * bfhi(cg_[k]) * bfhi(hg[k]);
        }
      }
    }
    u32x4 o;
#pragma unroll
    for (int k = 0; k < 4; ++k) o[k] = pk2(bflo(bg[k]) * y[2 * k], bfhi(bg[k]) * y[2 * k + 1]);
    *(u32x4*)(mix + (size_t)t * 1024 + cc) = o;
  }
  for (int it = blockIdx.x; it < T * 16 / NT; it += gridDim.x) {
    const int idx = it * NT + tid, t = idx >> 4, f = idx & 15;
    int ss, pos, S; tok_geom(t, ss, pos, S);
    const float x1 = bf2f(z[(size_t)t * INC + 1920 + f]), x2 = bf2f(z[(size_t)t * INC + 1936 + f]);
    const f32x2 cs = rope[pos * 16 + f];
    const bfu o1 = f2bf(x1 * cs[0] - x2 * cs[1]), o2 = f2bf(x1 * cs[1] + x2 * cs[0]);
#pragma unroll
    for (int h = 0; h < 8; ++h) { bfu* d = kh + ((size_t)h * T + t) * 96 + 64 + f; d[0] = o1; d[16] = o2; }
  }
  float* rs = (float*)(smem + SMEM_RS);
  {
    const bfu* wt = (const bfu*)(p.ws + OFF_WUQ);
    for (int idx = blockIdx.x; idx < 256 * 3; idx += gridDim.x) {
      int mt, nt; tile_map(idx, 3, mt, nt);
      const int m0 = mt * 256, n0 = nt * 256;
      __syncthreads();
      rms_rows(z + (size_t)m0 * INC + 1536, 256, rs);
      gemm_tile<false>(z + (size_t)m0 * INC + 1536, INC, wt + (size_t)n0 * 256, 256, 256, 256, smem,
        [&](int rl, int cl, const f32x4& vin, bool) {
          const int col = n0 + cl, head = col / 96, d = col - head * 96, t = m0 + rl;
          const float sc = rs[rl];
          f32x4 v = vin * sc;
          f32x4 pr;
#pragma unroll
          for (int k = 0; k < 4; ++k) pr[k] = __shfl_xor(v[k], 4);
          if (d >= 64) {
            int ss, pos, S; tok_geom(t, ss, pos, S);
            const int f = (d - 64) & 15;
            const f32x4 cs0 = *(const f32x4*)(rope + pos * 16 + f), cs1 = *(const f32x4*)(rope + pos * 16 + f + 2);
            const float co[4] = {cs0[0], cs0[2], cs1[0], cs1[2]}, si[4] = {cs0[1], cs0[3], cs1[1], cs1[3]};
            const bool first = d < 80;
#pragma unroll
            for (int k = 0; k < 4; ++k) v[k] = first ? v[k] * co[k] - pr[k] * si[k] : pr[k] * si[k] + v[k] * co[k];
          }
          *(u32x2*)(qh + ((size_t)head * T + t) * 96 + d) = u32x2{pk2(v[0], v[1]), pk2(v[2], v[3])};
        });
    }
  }
  {
    const bfu* wt = (const bfu*)(p.ws + OFF_WUKV);
    for (int idx = blockIdx.x; idx < 256 * 4; idx += gridDim.x) {
      int mt, nt; tile_map(idx, 4, mt, nt);
      const int m0 = mt * 256, n0 = nt * 256;
      __syncthreads();
      rms_rows(z + (size_t)m0 * INC + 1792, 128, rs);
      gemm_tile<true>(z + (size_t)m0 * INC + 1792, INC, wt + (size_t)n0 * 128, 128, 128, 256, smem,
        [&](int rl, int cl, const f32x4& v, bool tr) {
          const int head = (n0 + cl) >> 7, dd = cl & 127;
          if (!tr) {
            const float sc = rs[rl];
            *(u32x2*)(kh + ((size_t)head * T + m0 + rl) * 96 + dd) = u32x2{pk2(v[0] * sc, v[1] * sc), pk2(v[2] * sc, v[3] * sc)};
          } else {
            const f32x4 sc = *(const f32x4*)(rs + rl);
            const int tk = m0 + rl, key = tk & 63;
            const int pos = 32 * ((key >> 3) & 1) + 16 * (key >> 5) + 8 * ((key >> 4) & 1) + (key & 7);
            *(unsigned*)((unsigned char*)vT + (((size_t)head * (T / 64) + (tk >> 6)) * 64 + (dd - 64)) * 64 + pos) = pk4_fp8(v[0] * sc[0], v[1] * sc[1], v[2] * sc[2], v[3] * sc[3]);
          }
        });
    }
  }
}

DI void attn_item64(const Params& p, int seq_start, int S, int h, int q0, char* smem) {
  const int tid = opaque_tid(), lane = tid & 63, w = tid >> 6, l31 = lane & 31, hf = lane >> 5;
  const bfu* qh = (const bfu*)(p.ws + OFF_QH);
  const bfu* kh = (const bfu*)(p.ws + OFF_KH);
  const bfu* vT = (const bfu*)((const char*)p.out + OUT_OFF_VT);
  constexpr int KP = 144, KB = 64 * KP, VB = 64 * 80;
  char* qsp = smem + 2 * KB + 2 * VB + w * 8192 + lane * 16;
  {
#pragma unroll
    for (int a = 0; a < 2; ++a) {
      const bfu* qrow = qh + ((size_t)h * T + q0 + 64 * w + 32 * a + l31) * 96 + 32 * hf;
#pragma unroll
      for (int kk = 0; kk < 2; ++kk) {
        const u32x4 r0 = *(const u32x4*)(qrow + 64 * kk), r1 = *(const u32x4*)(qrow + 64 * kk + 8), r2 = *(const u32x4*)(qrow + 64 * kk + 16), r3 = *(const u32x4*)(qrow + 64 * kk + 24);
        u32x4 lo = {pk4_fp8(bflo(r0[0]), bfhi(r0[0]), bflo(r0[1]), bfhi(r0[1])), pk4_fp8(bflo(r0[2]), bfhi(r0[2]), bflo(r0[3]), bfhi(r0[3])),
                    pk4_fp8(bflo(r1[0]), bfhi(r1[0]), bflo(r1[1]), bfhi(r1[1])), pk4_fp8(bflo(r1[2]), bfhi(r1[2]), bflo(r1[3]), bfhi(r1[3]))};
        u32x4 hi = {pk4_fp8(bflo(r2[0]), bfhi(r2[0]), bflo(r2[1]), bfhi(r2[1])), pk4_fp8(bflo(r2[2]), bfhi(r2[2]), bflo(r2[3]), bfhi(r2[3])),
                    pk4_fp8(bflo(r3[0]), bfhi(r3[0]), bflo(r3[1]), bfhi(r3[1])), pk4_fp8(bflo(r3[2]), bfhi(r3[2]), bflo(r3[3]), bfhi(r3[3]))};
        if (kk == 1 && hf == 1) { lo = u32x4{0u, 0u, 0u, 0u}; hi = u32x4{0u, 0u, 0u, 0u}; }
        *(u32x4*)(qsp + (a * 4 + kk * 2) * 1024) = lo; *(u32x4*)(qsp + (a * 4 + kk * 2 + 1) * 1024) = hi;
      }
    }
  }
  f32x16 o[2][2];
#pragma unroll
  for (int a = 0; a < 2; ++a)
#pragma unroll
    for (int d = 0; d < 2; ++d)
#pragma unroll
      for (int r = 0; r < 16; ++r) o[a][d][r] = 0.f;
  float m[2] = {0.f, 0.f}, lsum[2] = {0.f, 0.f};
  const char* kbase = (const char*)(kh + ((size_t)h * T + seq_start) * 96);
  const unsigned char* vbase = (const unsigned char*)vT + ((size_t)h * (T / 64) + (seq_start >> 6)) * 4096;
  u32x4 rk[2]; u32x2 rv;
  auto gload = [&](int kt) {
    const char* kp = kbase + (size_t)kt * 12288;
    rk[0] = *(const u32x4*)(kp + tid * 16);
    if (tid < 256) rk[1] = *(const u32x4*)(kp + (tid + NT) * 16);
    rv = *(const u32x2*)(vbase + (size_t)kt * 4096 + tid * 8);
  };
  auto swrite = [&](int buf) {
    { const int key = tid / 12, part = tid % 12; const u32x4 r = rk[0];
      *(u32x2*)(smem + buf * KB + key * KP + part * 8) = u32x2{pk4_fp8(bflo(r[0]), bfhi(r[0]), bflo(r[1]), bfhi(r[1])), pk4_fp8(bflo(r[2]), bfhi(r[2]), bflo(r[3]), bfhi(r[3]))}; }
    if (tid < 256) { const int c = tid + NT, key = c / 12, part = c % 12; const u32x4 r = rk[1];
      *(u32x2*)(smem + buf * KB + key * KP + part * 8) = u32x2{pk4_fp8(bflo(r[0]), bfhi(r[0]), bflo(r[1]), bfhi(r[1])), pk4_fp8(bflo(r[2]), bfhi(r[2]), bflo(r[3]), bfhi(r[3]))}; }
    { const int d = tid >> 3, part = tid & 7; *(u32x2*)(smem + 2 * KB + buf * VB + d * 80 + part * 8) = rv; }
  };
  const int prow = (l31 & 0x13) | ((l31 & 4) << 1) | ((l31 & 8) >> 1);
  const int nkt = S / 64;
  __syncthreads();
  if (tid < 128) {
    char* kp = smem + (tid >> 6) * KB + (tid & 63) * KP + 96;
    *(u32x4*)kp = u32x4{0x38u, 0u, 0u, 0u}; *(u32x4*)(kp + 16) = u32x4{0u, 0u, 0u, 0u};
  }
  gload(0); swrite(0);
  __syncthreads();
#pragma unroll 1
  for (int kt = 0; kt < nkt; ++kt) {
    if (kt + 1 < nkt) gload(kt + 1);
    const char* Ks = smem + (kt & 1) * KB + prow * KP + hf * 32;
    const char* Vs = smem + 2 * KB + (kt & 1) * VB + l31 * 80 + hf * 32;
    f32x16 s[2][2];
    {
      __builtin_amdgcn_s_setprio(1);
      f32x16 zz;
#pragma unroll
      for (int r = 0; r < 16; ++r) zz[r] = 0.f;
#pragma unroll
      for (int kk = 0; kk < 2; ++kk) {
        const u32x4 a0 = *(const u32x4*)(Ks + kk * 64), a1 = *(const u32x4*)(Ks + kk * 64 + 16);
        const u32x4 b0 = *(const u32x4*)(Ks + 32 * KP + kk * 64), b1 = *(const u32x4*)(Ks + 32 * KP + kk * 64 + 16);
        const i32x8 kA0 = {(int)a0[0], (int)a0[1], (int)a0[2], (int)a0[3], (int)a1[0], (int)a1[1], (int)a1[2], (int)a1[3]};
        const i32x8 kA1 = {(int)b0[0], (int)b0[1], (int)b0[2], (int)b0[3], (int)b1[0], (int)b1[1], (int)b1[2], (int)b1[3]};
#pragma unroll
        for (int a = 0; a < 2; ++a) {
          const u32x4 q0v = *(const u32x4*)(qsp + (a * 4 + kk * 2) * 1024), q1v = *(const u32x4*)(qsp + (a * 4 + kk * 2 + 1) * 1024);
          const i32x8 qB = {(int)q0v[0], (int)q0v[1], (int)q0v[2], (int)q0v[3], (int)q1v[0], (int)q1v[1], (int)q1v[2], (int)q1v[3]};
          s[a][0] = __builtin_amdgcn_mfma_scale_f32_32x32x64_f8f6f4(kA0, qB, kk == 0 ? zz : s[a][0], 0, 0, 0, 0x7F7F7F7F, 0, 0x7F7F7F7F);
          s[a][1] = __builtin_amdgcn_mfma_scale_f32_32x32x64_f8f6f4(kA1, qB, kk == 0 ? zz : s[a][1], 0, 0, 0, 0x7F7F7F7F, 0, 0x7F7F7F7F);
        }
      }
      __builtin_amdgcn_s_setprio(0);
    }
    float mx[2];
#pragma unroll
    for (int a = 0; a < 2; ++a) {
      float t = s[a][0][0];
#pragma unroll
      for (int r = 1; r < 16; ++r) t = fmaxf(t, s[a][0][r]);
#pragma unroll
      for (int r = 0; r < 16; ++r) t = fmaxf(t, s[a][1][r]);
      mx[a] = fmaxf(t, __shfl_xor(t, 32));
    }
    const bool need0 = (kt == 0) || (mx[0] > 8.f), need1 = (kt == 0) || (mx[1] > 8.f);
    if (__any(need0 || need1)) {
#pragma unroll
      for (int a = 0; a < 2; ++a) {
        const bool need = a ? need1 : need0;
        const float want = need ? (kt == 0 ? mx[a] : fmaxf(mx[a], 0.f)) : 0.f;
        const unsigned mb = pk4_fp8(m[a] + want, 0.f, 0.f, 0.f) & 0xffu;
        const float mnew = __builtin_amdgcn_cvt_pk_f32_fp8((int)mb, false)[0];
        const float delta = mnew - m[a];
        const float alpha = (kt == 0) ? 1.f : __builtin_amdgcn_exp2f(-delta);
        m[a] = mnew;
        lsum[a] *= alpha;
#pragma unroll
        for (int r = 0; r < 16; ++r) { o[a][0][r] *= alpha; o[a][1][r] *= alpha; s[a][0][r] -= delta; s[a][1][r] -= delta; }
        if (hf == 1) *(unsigned*)(qsp + (a * 4 + 2) * 1024) = mb ^ 0x80u;
      }
    }
#pragma unroll
    for (int a = 0; a < 2; ++a) {
      i32x8 pb;
      float ps = 0.f;
#pragma unroll
      for (int sub = 0; sub < 2; ++sub)
#pragma unroll
        for (int u = 0; u < 4; ++u) {
          const float e0 = __builtin_amdgcn_exp2f(s[a][sub][4 * u]), e1 = __builtin_amdgcn_exp2f(s[a][sub][4 * u + 1]);
          const float e2 = __builtin_amdgcn_exp2f(s[a][sub][4 * u + 2]), e3 = __builtin_amdgcn_exp2f(s[a][sub][4 * u + 3]);
          ps += (e0 + e1) + (e2 + e3);
          pb[4 * sub + u] = (int)pk4_fp8(e0, e1, e2, e3);
        }
      lsum[a] += ps;
#pragma unroll
      for (int dt = 0; dt < 2; ++dt) {
        const u32x4 lo = *(const u32x4*)(Vs + dt * 32 * 80), hi = *(const u32x4*)(Vs + dt * 32 * 80 + 16);
        const i32x8 va = {(int)lo[0], (int)lo[1], (int)lo[2], (int)lo[3], (int)hi[0], (int)hi[1], (int)hi[2], (int)hi[3]};
        o[a][dt] = __builtin_amdgcn_mfma_scale_f32_32x32x64_f8f6f4(va, pb, o[a][dt], 0, 0, 0, 0x7F7F7F7F, 0, 0x7F7F7F7F);
      }
    }
    if (kt + 1 < nkt) swrite((kt + 1) & 1);
    __syncthreads();
  }
  bfu* mix = (bfu*)p.out;
#pragma unroll
  for (int a = 0; a < 2; ++a) {
    const float lt = lsum[a] + __shfl_xor(lsum[a], 32);
    const float inv = 1.f / lt;
    const int t = q0 + 64 * w + 32 * a + l31;
#pragma unroll
    for (int g = 0; g < 4; ++g) {
      const int d = 8 * g + 4 * hf;
      u32x2 x0 = {pk2(o[a][0][4 * g] * inv, o[a][0][4 * g + 1] * inv), pk2(o[a][0][4 * g + 2] * inv, o[a][0][4 * g + 3] * inv)};
      u32x2 x1 = {pk2(o[a][1][4 * g] * inv, o[a][1][4 * g + 1] * inv), pk2(o[a][1][4 * g + 2] * inv, o[a][1][4 * g + 3] * inv)};
      *(u32x2*)(mix + (size_t)t * 1024 + 512 + h * 64 + d) = x0;
      *(u32x2*)(mix + (size_t)t * 1024 + 512 + h * 64 + 32 + d) = x1;
    }
  }
}

DI void phase3(const Params& p, char* smem) {
  for (int i = blockIdx.x; i < 1024; i += gridDim.x) {
    if (i < 512) { const int qb = i & 31, h = (i >> 5) & 7, sq = i >> 8; attn_item64(p, sq * 16384, 16384, h, sq * 16384 + qb * 512, smem); }
    else { const int j = i - 512, qb = j & 7, h = (j >> 3) & 7, sq = j >> 6; attn_item64(p, TPROMPT + sq * 4096, 4096, h, TPROMPT + sq * 4096 + qb * 512, smem); }
  }
}

DI void phase4(const Params& p, char* smem) {
  const bfu* wt = (const bfu*)(p.ws + OFF_WO);
  const bfu* mix = (const bfu*)p.out;
  bfu* y1 = (bfu*)(p.ws + OFF_Y1);
  const int lane = opaque_tid() & 63, l31 = lane & 31, hf = lane >> 5;
  for (int idx = blockIdx.x; idx < 256 * 4; idx += gridDim.x) {
    int mt, nt; tile_map(idx, 4, mt, nt);
    const int m0 = mt * 256, n0 = nt * 256;
    const float* xr = xrow(p, m0);
    gemm_tile<false>(mix + (size_t)m0 * 1024, 1024, wt + (size_t)n0 * 1024, 1024, 1024, 256, smem,
      [&](int rl, int cl, const f32x4& v, bool) {
        const f32x4 xv = *(const f32x4*)(xr + (size_t)rl * 1024 + n0 + cl);
        const f32x4 y = v + ALPHA * xv;
        *(u32x2*)(y1 + (size_t)(m0 + rl) * 1024 + n0 + cl) = u32x2{pk2(y[0], y[1]), pk2(y[2], y[3])};
      });
  }
}

DI void phase5(const Params& p) {
  const bfu* y1 = (const bfu*)(p.ws + OFF_Y1);
  bfu* x1b = (bfu*)(p.ws + OFF_X1B);
  const int tid = opaque_tid(), lane = tid & 63, w = tid >> 6;
  f32x4 g[4], b[4];
#pragma unroll
  for (int i = 0; i < 4; ++i) { g[i] = *(const f32x4*)(p.ln1g + 4 * lane + 256 * i); b[i] = *(const f32x4*)(p.ln1b + 4 * lane + 256 * i); }
  for (int t = blockIdx.x * NW + w; t < T; t += gridDim.x * NW) {
    const bfu* yr = y1 + (size_t)t * 1024;
    f32x4 v[4];
    float s = 0.f;
#pragma unroll
    for (int i = 0; i < 4; ++i) { const u32x2 yw = *(const u32x2*)(yr + 4 * lane + 256 * i); v[i] = f32x4{bflo(yw[0]), bfhi(yw[0]), bflo(yw[1]), bfhi(yw[1])}; s += v[i][0] + v[i][1] + v[i][2] + v[i][3]; }
    const float mu = wave_sum(s) * (1.f / 1024.f);
    float q = 0.f;
#pragma unroll
    for (int i = 0; i < 4; ++i)
#pragma unroll
      for (int k = 0; k < 4; ++k) { const float d = v[i][k] - mu; q += d * d; }
    const float rstd = rsqrtf(wave_sum(q) * (1.f / 1024.f) + LN_EPS);
#pragma unroll
    for (int i = 0; i < 4; ++i) {
      f32x4 o;
#pragma unroll
      for (int k = 0; k < 4; ++k) o[k] = (v[i][k] - mu) * rstd * g[i][k] + b[i][k];
      u32x2 ob = {pk2(o[0], o[1]), pk2(o[2], o[3])};
      *(u32x2*)(x1b + (size_t)t * 1024 + 4 * lane + 256 * i) = ob;
    }
  }
  const size_t gtid = (size_t)blockIdx.x * NT + tid, gstride = (size_t)gridDim.x * NT;
  unsigned char* ub = (unsigned char*)(p.ws + OFF_UB); unsigned char* vb = (unsigned char*)(p.ws + OFF_VB);
  for (size_t i = gtid; i < (size_t)16384 * 1024 / 32; i += gstride) {
    u32x4 ou, ov;
#pragma unroll
    for (int k = 0; k < 4; ++k) {
      const f32x4 a0 = *(const f32x4*)(p.pu + i * 32 + 8 * k), a1 = *(const f32x4*)(p.pu + i * 32 + 8 * k + 4);
      const f32x4 c0 = *(const f32x4*)(p.pv + i * 32 + 8 * k), c1 = *(const f32x4*)(p.pv + i * 32 + 8 * k + 4);
      unsigned wu = 0, wv = 0;
      wu = __builtin_amdgcn_cvt_scalef32_pk_fp4_f32(wu, a0[0] * U_SCALE, a0[1] * U_SCALE, 1.0f, 0);
      wu = __builtin_amdgcn_cvt_scalef32_pk_fp4_f32(wu, a0[2] * U_SCALE, a0[3] * U_SCALE, 1.0f, 1);
      wu = __builtin_amdgcn_cvt_scalef32_pk_fp4_f32(wu, a1[0] * U_SCALE, a1[1] * U_SCALE, 1.0f, 2);
      wu = __builtin_amdgcn_cvt_scalef32_pk_fp4_f32(wu, a1[2] * U_SCALE, a1[3] * U_SCALE, 1.0f, 3);
      wv = __builtin_amdgcn_cvt_scalef32_pk_fp4_f32(wv, c0[0] * V_SCALE, c0[1] * V_SCALE, 1.0f, 0);
      wv = __builtin_amdgcn_cvt_scalef32_pk_fp4_f32(wv, c0[2] * V_SCALE, c0[3] * V_SCALE, 1.0f, 1);
      wv = __builtin_amdgcn_cvt_scalef32_pk_fp4_f32(wv, c1[0] * V_SCALE, c1[1] * V_SCALE, 1.0f, 2);
      wv = __builtin_amdgcn_cvt_scalef32_pk_fp4_f32(wv, c1[2] * V_SCALE, c1[3] * V_SCALE, 1.0f, 3);
      ou[k] = wu; ov[k] = wv;
    }
    const size_t e = i >> 5, c0 = (i & 31) * 32, dst = (c0 >> 8) * ((size_t)16384 * 128) + e * 128 + ((c0 & 255) >> 1);
    *(u32x4*)(ub + dst) = ou; *(u32x4*)(vb + dst) = ov;
  }
}

DI void phase6(const Params& p, char* smem) {
  const bfu* wt = (const bfu*)(p.ws + OFF_WQ);
  const bfu* x1b = (const bfu*)(p.ws + OFF_X1B);
  bfu* qp = (bfu*)(p.ws + OFF_QP);
  const int lane = opaque_tid() & 63, l31 = lane & 31, hf = lane >> 5;
  for (int idx = blockIdx.x; idx < 256 * 8; idx += gridDim.x) {
    int mt, nt; tile_map(idx, 8, mt, nt);
    const int m0 = mt * 256, n0 = nt * 256;
    gemm_tile<false>(x1b + (size_t)m0 * 1024, 1024, wt + (size_t)n0 * 1024, 1024, 1024, 256, smem,
      [&](int rl, int cl, const f32x4& v, bool) {
        *(u32x2*)(qp + (size_t)(m0 + rl) * 2048 + n0 + cl) = u32x2{pk2(v[0], v[1]), pk2(v[2], v[3])};
      });
  }
}

DI unsigned fsort(float f) { const unsigned u = __float_as_uint(f); return u ^ ((unsigned)((int)u >> 31) | 0x80000000u); }
DI float funsort(unsigned k) { return __uint_as_float(k ^ ((~(unsigned)((int)k >> 31)) | 0x80000000u)); }
#define CE(i, j) { const unsigned hi_ = a[i] > a[j] ? a[i] : a[j], lo_ = a[i] > a[j] ? a[j] : a[i]; a[i] = hi_; a[j] = lo_; }
DI void sort16(unsigned (&a)[16]) {
  CE(0,1) CE(2,3) CE(0,2) CE(1,3) CE(1,2) CE(4,5) CE(6,7) CE(4,6) CE(5,7) CE(5,6) CE(0,4) CE(2,6) CE(2,4) CE(1,5) CE(3,7) CE(3,5) CE(1,2) CE(3,4) CE(5,6) CE(8,9) CE(10,11) CE(8,10) CE(9,11) CE(9,10) CE(12,13) CE(14,15) CE(12,14) CE(13,15) CE(13,14) CE(8,12) CE(10,14) CE(10,12) CE(9,13) CE(11,15) CE(11,13) CE(9,10) CE(11,12) CE(13,14) CE(0,8) CE(4,12) CE(4,8) CE(2,10) CE(6,14) CE(6,10) CE(2,4) CE(6,8) CE(10,12) CE(1,9) CE(5,13) CE(5,9) CE(3,11) CE(7,15) CE(7,11) CE(3,5) CE(7,9) CE(11,13) CE(1,2) CE(3,4) CE(5,6) CE(7,8) CE(9,10) CE(11,12) CE(13,14)
}
DI void merge16(unsigned (&a)[16], const unsigned (&b)[16]) {
#pragma unroll
  for (int i = 0; i < 16; ++i) a[i] = a[i] > b[15 - i] ? a[i] : b[15 - i];
#pragma unroll
  for (int d = 8; d >= 1; d >>= 1)
#pragma unroll
    for (int i = 0; i < 16; ++i)
      if ((i & d) == 0) CE(i, i + d)
}
#undef CE
DI void topk_item(const Params& p, int mt, int h, char* smem) {
  const int tid = opaque_tid(), lane = tid & 63, w = tid >> 6, l31 = lane & 31, hf = lane >> 5;
  const int m0 = mt * 256;
  const bfu* qp = (const bfu*)(p.ws + OFF_QP);
  char* Qs = smem; char* Ks = smem + 69632;
  unsigned char* IL = (unsigned char*)(smem + 104448) + w * 1024 + l31 * 32;
  unsigned L[2][16];
#pragma unroll
  for (int j = 0; j < 2; ++j) {
    const bfu* kj = (const bfu*)(p.ws + (j ? OFF_K2 : OFF_K1)) + (size_t)h * 128 * 128;
    __syncthreads();
#pragma unroll
    for (int i = 0; i < 8; ++i) {
      const int c = tid + NT * i, row = c >> 4, part = c & 15;
      *(u32x4*)(Qs + row * 272 + part * 16) = *(const u32x4*)(qp + (size_t)(m0 + row) * 2048 + h * 256 + j * 128 + part * 8);
      if (i < 4) *(u32x4*)(Ks + row * 272 + part * 16) = *(const u32x4*)(kj + row * 128 + part * 8);
    }
    __syncthreads();
    f32x16 acc[4];
#pragma unroll
    for (int rt = 0; rt < 4; ++rt)
#pragma unroll
      for (int r = 0; r < 16; ++r) acc[rt][r] = 0.f;
#pragma unroll
    for (int ks = 0; ks < 8; ++ks) {
      const bf16x8 b = *(const bf16x8*)(Qs + (32 * w + l31) * 272 + (2 * ks + hf) * 16);
#pragma unroll
      for (int rt = 0; rt < 4; ++rt) {
        const bf16x8 a = *(const bf16x8*)(Ks + (rt * 32 + l31) * 272 + (2 * ks + hf) * 16);
        acc[rt] = mfma32(a, b, acc[rt]);
      }
    }
    unsigned g1[16], g2[16], g3[16];
#pragma unroll
    for (int r = 0; r < 16; ++r) {
      L[j][r] = (fsort(acc[0][r]) & ~0x7Fu) | (unsigned)(0 * 32 + crow(r, hf));
      g1[r] = (fsort(acc[1][r]) & ~0x7Fu) | (unsigned)(1 * 32 + crow(r, hf));
      g2[r] = (fsort(acc[2][r]) & ~0x7Fu) | (unsigned)(2 * 32 + crow(r, hf));
      g3[r] = (fsort(acc[3][r]) & ~0x7Fu) | (unsigned)(3 * 32 + crow(r, hf));
    }
    sort16(L[j]); sort16(g1); sort16(g2); sort16(g3);
    merge16(L[j], g1); merge16(g2, g3); merge16(L[j], g2);
    unsigned O[16];
#pragma unroll
    for (int i = 0; i < 16; ++i) O[i] = (unsigned)__shfl_xor((int)L[j][i], 32);
    merge16(L[j], O);
  }
  if (hf == 0) {
#pragma unroll
    for (int a = 0; a < 16; ++a) { IL[a] = (unsigned char)(L[0][a] & 0x7Fu); IL[16 + a] = (unsigned char)(L[1][a] & 0x7Fu); }
  }
  __syncthreads();
  float v1[16], v2[16];
#pragma unroll
  for (int a = 0; a < 16; ++a) { v1[a] = funsort(L[0][a] & ~0x7Fu); v2[a] = funsort(L[1][a] & ~0x7Fu); }
  unsigned C[16], c1[16], c2[16], c3[16];
#define CK(a, b) ((fsort(v1[a] + v2[b]) & ~0xFFu) | (unsigned)((a) * 16 + (b)))
#pragma unroll
  for (int b = 0; b < 16; ++b) C[b] = CK(0, b);
#pragma unroll
  for (int b = 0; b < 8; ++b) c1[b] = CK(1, b);
#pragma unroll
  for (int b = 0; b < 5; ++b) c1[8 + b] = CK(2, b);
  c1[13] = 0u; c1[14] = 0u; c1[15] = 0u;
#pragma unroll
  for (int b = 0; b < 4; ++b) c2[b] = CK(3, b);
#pragma unroll
  for (int b = 0; b < 3; ++b) c2[4 + b] = CK(4, b);
#pragma unroll
  for (int b = 0; b < 2; ++b) { c2[7 + b] = CK(5, b); c2[9 + b] = CK(6, b); c2[11 + b] = CK(7, b); }
  c2[13] = 0u; c2[14] = 0u; c2[15] = 0u;
#pragma unroll
  for (int a = 0; a < 8; ++a) { c3[a] = CK(8 + a, 0); c3[8 + a] = 0u; }
#undef CK
  sort16(C); sort16(c1); sort16(c2); sort16(c3);
  merge16(C, c1); merge16(c2, c3); merge16(C, c2);
  const float mx = funsort(C[0] & ~0xFFu);
  float e[16], sum = 0.f;
#pragma unroll
  for (int i = 0; i < 16; ++i) { e[i] = __expf(funsort(C[i] & ~0xFFu) - mx); sum += e[i]; }
  const float inv = 1.f / sum;
  const int t = m0 + 32 * w + l31;
  const size_t ob = ((size_t)t * 8 + h) * 16;
  if (hf == 0) {
    bfu* eo = (bfu*)(p.ws + OFF_EIDX) + ob;
#pragma unroll
    for (int i8 = 0; i8 < 2; ++i8) {
      u32x4 ev;
#pragma unroll
      for (int k = 0; k < 4; ++k) {
        const unsigned c0 = C[8 * i8 + 2 * k], c1 = C[8 * i8 + 2 * k + 1];
        const unsigned e0 = (unsigned)IL[(c0 >> 4) & 15] * 128u + (unsigned)IL[16 + (c0 & 15)], e1 = (unsigned)IL[(c1 >> 4) & 15] * 128u + (unsigned)IL[16 + (c1 & 15)];
        ev[k] = e0 | (e1 << 16);
      }
      *(u32x4*)(eo + 8 * i8) = ev;
    }
  } else {
    bfu* go = (bfu*)(p.ws + OFF_GW) + ob;
#pragma unroll
    for (int i8 = 0; i8 < 2; ++i8) {
      u32x4 gv;
#pragma unroll
      for (int k = 0; k < 4; ++k) gv[k] = pk2(e[8 * i8 + 2 * k] * inv, e[8 * i8 + 2 * k + 1] * inv);
      *(u32x4*)(go + 8 * i8) = gv;
    }
  }
}

DI void phase7(const Params& p, char* smem) {
  for (int i = blockIdx.x; i < 2048; i += gridDim.x) topk_item(p, i >> 3, i & 7, smem);
}

DI void phase8a(const Params& p) {
  const int tid = opaque_tid(), lane = tid & 63, w = tid >> 6, r = lane & 7, jg = lane >> 3;
  const int s = blockIdx.x & 3, par = (blockIdx.x >> 2) & 1, nvw = (gridDim.x >> 3) * NW, vw = (blockIdx.x >> 3) * NW + w;
  const unsigned char* u4 = (const unsigned char*)(p.ws + OFF_UB) + (size_t)s * (16384 * 128) + 16 * r;
  const bfu* eidx = (const bfu*)(p.ws + OFF_EIDX);
  bfu* part = (bfu*)(p.ws + OFF_PART) + (size_t)s * T * 128;
  const int b2 = (lane >> 2) & 1, b1 = (lane >> 1) & 1, b0 = lane & 1;
  const bfu* x1b = (const bfu*)(p.ws + OFF_X1B);
  constexpr int TH = T / 2;
  u32x4 xA[4], xB[4]; u32x4 eA[2], eB[2]; u32x4 dA[16], dB[16];
  auto load1 = [&](int j, u32x4 (&xq)[4], u32x4 (&ev)[2]) {
    j = j < TH ? j : TH - 1;
    const int t = 2 * j + par;
    const bfu* xr = x1b + (size_t)t * 1024 + 256 * s + 32 * r;
#pragma unroll
    for (int k = 0; k < 4; ++k) xq[k] = *(const u32x4*)(xr + 8 * k);
    ev[0] = *(const u32x4*)(eidx + (size_t)t * 128 + jg * 16); ev[1] = *(const u32x4*)(eidx + (size_t)t * 128 + jg * 16 + 8);
  };
  auto load2 = [&](const u32x4 (&ev)[2], u32x4 (&d)[16]) {
#pragma unroll
    for (int i = 0; i < 16; ++i) d[i] = *(const u32x4*)(u4 + (size_t)((ev[i >> 3][(i >> 1) & 3] >> (16 * (i & 1))) & 16383u) * 128);
  };
  auto comp = [&](int j, const u32x4 (&xq)[4], const u32x4 (&d)[16]) {
    const int t = 2 * j + par;
    f32x2 xx[16];
#pragma unroll
    for (int k = 0; k < 4; ++k)
#pragma unroll
      for (int b = 0; b < 4; ++b) { const unsigned w0 = xq[k][b]; xx[4 * k + b] = f32x2{bflo(w0), bfhi(w0)}; }
    float pr[16];
#pragma unroll
    for (int i = 0; i < 16; ++i) {
      f32x2 a2 = {0.f, 0.f};
#pragma unroll
      for (int k = 0; k < 4; ++k) {
        a2 += __builtin_amdgcn_cvt_scalef32_pk_f32_fp4(d[i][k], 1.0f, 0) * xx[4 * k + 0];
        a2 += __builtin_amdgcn_cvt_scalef32_pk_f32_fp4(d[i][k], 1.0f, 1) * xx[4 * k + 1];
        a2 += __builtin_amdgcn_cvt_scalef32_pk_f32_fp4(d[i][k], 1.0f, 2) * xx[4 * k + 2];
        a2 += __builtin_amdgcn_cvt_scalef32_pk_f32_fp4(d[i][k], 1.0f, 3) * xx[4 * k + 3];
      }
      pr[i] = a2[0] + a2[1];
    }
    float q8[8], q4[4], q2[2];
#pragma unroll
    for (int k = 0; k < 8; ++k) q8[k] = (b2 ? pr[8 + k] : pr[k]) + __shfl_xor(b2 ? pr[k] : pr[8 + k], 4);
#pragma unroll
    for (int k = 0; k < 4; ++k) q4[k] = (b1 ? q8[4 + k] : q8[k]) + __shfl_xor(b1 ? q8[k] : q8[4 + k], 2);
#pragma unroll
    for (int k = 0; k < 2; ++k) q2[k] = (b0 ? q4[2 + k] : q4[k]) + __shfl_xor(b0 ? q4[k] : q4[2 + k], 1);
    *(unsigned*)(part + (size_t)t * 128 + 2 * lane) = pk2(q2[0], q2[1]);
  };
  if ((int)(blockIdx.x >> 3) < (int)(gridDim.x >> 3)) {
    load1(vw, xA, eA); load2(eA, dA); load1(vw + nvw, xB, eB);
    for (int j = vw; j < TH; j += 2 * nvw) {
      load2(eB, dB);
      comp(j, xA, dA);
      load1(j + 2 * nvw, xA, eA);
      if (j + nvw < TH) {
        load2(eA, dA);
        comp(j + nvw, xB, dB);
        load1(j + 3 * nvw, xB, eB);
      }
    }
  }
}
DI void phase8b(const Params& p) {
  const int tid = opaque_tid(), lane = tid & 63, w = tid >> 6;
  const bfu* part = (const bfu*)(p.ws + OFF_PART);
  bfu* gw = (bfu*)(p.ws + OFF_GW);
  for (int t = blockIdx.x * NW + w; t < T; t += gridDim.x * NW) {
    f32x2 a = {0.f, 0.f};
#pragma unroll
    for (int s = 0; s < 4; ++s) { const unsigned pw = *(const unsigned*)(part + ((size_t)s * T + t) * 128 + 2 * lane); a += f32x2{bflo(pw), bfhi(pw)}; }
    a *= (1.f / U_SCALE);
    const unsigned gq = *(const unsigned*)(gw + (size_t)t * 128 + 2 * lane);
    const f32x2 g = {bflo(gq), bfhi(gq)};
    f32x2 c;
    c[0] = g[0] * 0.5f * a[0] * (1.f + erff(a[0] * 0.7071067811865476f)) * (1.f / V_SCALE);
    c[1] = g[1] * 0.5f * a[1] * (1.f + erff(a[1] * 0.7071067811865476f)) * (1.f / V_SCALE);
    *(unsigned*)(gw + (size_t)t * 128 + 2 * lane) = pk2(c[0], c[1]);
  }
}
DI void phase8c(const Params& p) {
  const int tid = opaque_tid(), lane = tid & 63, w = tid >> 6, r = lane & 7, jg = lane >> 3;
  const int s = blockIdx.x & 3, par = (blockIdx.x >> 2) & 1, nvw = (gridDim.x >> 3) * NW, vw = (blockIdx.x >> 3) * NW + w;
  const unsigned char* v4 = (const unsigned char*)(p.ws + OFF_VB) + (size_t)s * (16384 * 128) + 16 * r;
  const bfu* eidx = (const bfu*)(p.ws + OFF_EIDX);
  const bfu* gw = (const bfu*)(p.ws + OFF_GW);
  const int b5 = lane >> 5, b4 = (lane >> 4) & 1, b3 = (lane >> 3) & 1;
  constexpr int TH = T / 2;
  u32x4 cA[2], cB[2]; u32x4 eA[2], eB[2]; u32x4 dA[16], dB[16];
  auto load1 = [&](int j, u32x4 (&cv)[2], u32x4 (&ev)[2]) {
    j = j < TH ? j : TH - 1;
    const int t = 2 * j + par;
#pragma unroll
    for (int k = 0; k < 2; ++k) { cv[k] = *(const u32x4*)(gw + (size_t)t * 128 + jg * 16 + 8 * k); ev[k] = *(const u32x4*)(eidx + (size_t)t * 128 + jg * 16 + 8 * k); }
  };
  auto load2 = [&](const u32x4 (&ev)[2], u32x4 (&d)[16]) {
#pragma unroll
    for (int i = 0; i < 16; ++i) d[i] = *(const u32x4*)(v4 + (size_t)((ev[i >> 3][(i >> 1) & 3] >> (16 * (i & 1))) & 16383u) * 128);
  };
  auto comp = [&](int j, const u32x4 (&cv)[2], const u32x4 (&d)[16]) {
    const int t = 2 * j + par;
    const int col = 256 * s + 32 * r + 16 * b5 + 8 * b4 + 4 * b3;
    float* o = p.out + (size_t)t * 1024 + col;
    const u32x2 xw = *(const u32x2*)((const bfu*)(p.ws + OFF_X1B) + (size_t)t * 1024 + col);
    f32x2 acc[16];
#pragma unroll
    for (int k = 0; k < 16; ++k) acc[k] = f32x2{0.f, 0.f};
#pragma unroll
    for (int i = 0; i < 16; ++i) {
      const unsigned cw = cv[i >> 3][(i >> 1) & 3];
      const float ci = (i & 1) ? bfhi(cw) : bflo(cw);
      const f32x2 c2 = {ci, ci};
#pragma unroll
      for (int k = 0; k < 4; ++k) {
        acc[4 * k + 0] += c2 * __builtin_amdgcn_cvt_scalef32_pk_f32_fp4(d[i][k], 1.0f, 0);
        acc[4 * k + 1] += c2 * __builtin_amdgcn_cvt_scalef32_pk_f32_fp4(d[i][k], 1.0f, 1);
        acc[4 * k + 2] += c2 * __builtin_amdgcn_cvt_scalef32_pk_f32_fp4(d[i][k], 1.0f, 2);
        acc[4 * k + 3] += c2 * __builtin_amdgcn_cvt_scalef32_pk_f32_fp4(d[i][k], 1.0f, 3);
      }
    }
    float v[32], q16[16], q8[8], q4[4];
#pragma unroll
    for (int k = 0; k < 16; ++k) { v[2 * k] = acc[k][0]; v[2 * k + 1] = acc[k][1]; }
#pragma unroll
    for (int k = 0; k < 16; ++k) q16[k] = (b5 ? v[16 + k] : v[k]) + __shfl_xor(b5 ? v[k] : v[16 + k], 32);
#pragma unroll
    for (int k = 0; k < 8; ++k) q8[k] = (b4 ? q16[8 + k] : q16[k]) + __shfl_xor(b4 ? q16[k] : q16[8 + k], 16);
#pragma unroll
    for (int k = 0; k < 4; ++k) q4[k] = (b3 ? q8[4 + k] : q8[k]) + __shfl_xor(b3 ? q8[k] : q8[4 + k], 8);
    *(f32x4*)o = f32x4{ALPHA * bflo(xw[0]) + q4[0], ALPHA * bfhi(xw[0]) + q4[1], ALPHA * bflo(xw[1]) + q4[2], ALPHA * bfhi(xw[1]) + q4[3]};
  };
  if ((int)(blockIdx.x >> 3) < (int)(gridDim.x >> 3)) {
    load1(vw, cA, eA); load2(eA, dA); load1(vw + nvw, cB, eB);
    for (int j = vw; j < TH; j += 2 * nvw) {
      load2(eB, dB);
      comp(j, cA, dA);
      load1(j + 2 * nvw, cA, eA);
      if (j + nvw < TH) {
        load2(eA, dA);
        comp(j + nvw, cB, dB);
        load1(j + 3 * nvw, cB, eB);
      }
    }
  }
}
DI void phase8d(const Params& p) {
  const int tid = opaque_tid(), lane = tid & 63, w = tid >> 6;
  f32x4 g[4], b[4];
#pragma unroll
  for (int i = 0; i < 4; ++i) { g[i] = *(const f32x4*)(p.ln2g + 4 * lane + 256 * i); b[i] = *(const f32x4*)(p.ln2b + 4 * lane + 256 * i); }
  for (int t = blockIdx.x * NW + w; t < T; t += gridDim.x * NW) {
    float* yr = p.out + (size_t)t * 1024;
    f32x4 v[4];
    float s = 0.f;
#pragma unroll
    for (int i = 0; i < 4; ++i) { v[i] = *(const f32x4*)(yr + 4 * lane + 256 * i); s += v[i][0] + v[i][1] + v[i][2] + v[i][3]; }
    const float mu = wave_sum(s) * (1.f / 1024.f);
    float q = 0.f;
#pragma unroll
    for (int i = 0; i < 4; ++i)
#pragma unroll
      for (int k = 0; k < 4; ++k) { const float d = v[i][k] - mu; q += d * d; }
    const float rstd = rsqrtf(wave_sum(q) * (1.f / 1024.f) + LN_EPS);
#pragma unroll
    for (int i = 0; i < 4; ++i) {
      f32x4 o;
#pragma unroll
      for (int k = 0; k < 4; ++k) o[k] = (v[i][k] - mu) * rstd * g[i][k] + b[i][k];
      *(f32x4*)(yr + 4 * lane + 256 * i) = o;
    }
  }
}

DI void grid_barrier(unsigned* ctr, unsigned& target) {
  asm volatile("s_waitcnt vmcnt(0)" ::: "memory");
  __syncthreads();
  if (threadIdx.x == 0) {
    __builtin_amdgcn_fence(__ATOMIC_RELEASE, "agent");
    asm volatile("s_waitcnt vmcnt(0)" ::: "memory");
    target += gridDim.x;
    __hip_atomic_fetch_add(ctr, 1u, __ATOMIC_RELAXED, __HIP_MEMORY_SCOPE_AGENT);
    while (__hip_atomic_load(ctr, __ATOMIC_RELAXED, __HIP_MEMORY_SCOPE_AGENT) < target) __builtin_amdgcn_s_sleep(2);
    __builtin_amdgcn_fence(__ATOMIC_ACQUIRE, "agent");
    asm volatile("s_waitcnt vmcnt(0)" ::: "memory");
  }
  __syncthreads();
}

template <int PH>
__global__ void __launch_bounds__(512) mega(Params p) {
  extern __shared__ __attribute__((aligned(16))) char smem[];
  cg::grid_group grid = cg::this_grid();
  unsigned* bar = (unsigned*)(p.ws + OFF_BAR);
  unsigned bar_target = 0;
  if (PH < 0 || PH == 0) phase0(p, smem);
  if (PH < 0) {
    if (p.ws == nullptr) grid.sync();
    grid_barrier(bar, bar_target);
  }
  if (PH < 0 || PH == 1) phase1(p, smem);
  if (PH < 0) grid_barrier(bar, bar_target);
  if (PH < 0 || PH == 2) phase2(p, smem);
  if (PH < 0) grid_barrier(bar, bar_target);
  if (PH < 0 || PH == 3) phase3(p, smem);
  if (PH < 0) grid_barrier(bar, bar_target);
  if (PH < 0 || PH == 4) phase4(p, smem);
  if (PH < 0) grid_barrier(bar, bar_target);
  if (PH < 0 || PH == 5) phase5(p);
  if (PH < 0) grid_barrier(bar, bar_target);
  if (PH < 0 || PH == 6) phase6(p, smem);
  if (PH < 0) grid_barrier(bar, bar_target);
  if (PH < 0 || PH == 7) phase7(p, smem);
  if (PH < 0) grid_barrier(bar, bar_target);
  if (PH < 0 || PH == 8) phase8a(p);
  if (PH < 0) grid_barrier(bar, bar_target);
  if (PH < 0 || PH == 9) phase8b(p);
  if (PH < 0) grid_barrier(bar, bar_target);
  if (PH < 0 || PH == 10) phase8c(p);
  if (PH < 0) grid_barrier(bar, bar_target);
  if (PH < 0 || PH == 11) phase8d(p);
}

template <int PH>
static void launch_phase(const Params& p, int grid, hipStream_t stream) {
  hipFuncSetAttribute((const void*)mega<PH>, hipFuncAttributeMaxDynamicSharedMemorySize, SMEM_BYTES);
  hipLaunchKernelGGL(mega<PH>, dim3(grid), dim3(NT), SMEM_BYTES, stream, p);
}

extern "C" void kernel_launch(void* const* d_in, const int* in_sizes, int n_in, void* d_out, int out_size, void* d_ws, size_t ws_size, hipStream_t stream) {
  static int grid_blocks = 0;
  if (!grid_blocks) {
    int dev = 0, cus = 0, per_cu = 0;
    hipGetDevice(&dev);
    hipDeviceGetAttribute(&cus, hipDeviceAttributeMultiprocessorCount, dev);
    hipFuncSetAttribute((const void*)mega<-1>, hipFuncAttributeMaxDynamicSharedMemorySize, SMEM_BYTES);
    hipOccupancyMaxActiveBlocksPerMultiprocessor(&per_cu, (const void*)mega<-1>, NT, SMEM_BYTES);
    if (per_cu < 1) per_cu = 1;
    if (per_cu > 1) per_cu = 1;
    grid_blocks = cus * per_cu;
    fprintf(stderr, "kernel_launch: cus %d per_cu %d grid %d ws %zu\n", cus, per_cu, grid_blocks, ws_size);
  }
  Params p{};
  p.xp = (const float*)d_in[0]; p.xs = (const float*)d_in[1]; p.w_in = (const float*)d_in[2]; p.conv_w = (const float*)d_in[3];
  p.qng = (const float*)d_in[4]; p.w_uq = (const float*)d_in[5]; p.kvng = (const float*)d_in[6]; p.w_ukv = (const float*)d_in[7];
  p.w_o = (const float*)d_in[8]; p.ln1g = (const float*)d_in[9]; p.ln1b = (const float*)d_in[10]; p.pwq = (const float*)d_in[11];
  p.pk1 = (const float*)d_in[12]; p.pk2 = (const float*)d_in[13]; p.pu = (const float*)d_in[14]; p.pv = (const float*)d_in[15];
  p.ln2g = (const float*)d_in[16]; p.ln2b = (const float*)d_in[17];
  p.out = (float*)d_out; p.ws = (char*)d_ws;
  for (int i = 0; i < 16; ++i) p.inv_freq[i] = 1.0 / pow(10000.0, (double)(2 * i) / 32.0);
#if MULTI_LAUNCH
  launch_phase<0>(p, grid_blocks, stream); launch_phase<1>(p, grid_blocks, stream); launch_phase<2>(p, grid_blocks, stream);
  launch_phase<3>(p, grid_blocks, stream); launch_phase<4>(p, grid_blocks, stream); launch_phase<5>(p, grid_blocks, stream);
  launch_phase<6>(p, grid_blocks, stream); launch_phase<7>(p, grid_blocks, stream); launch_phase<8>(p, grid_blocks, stream); launch_phase<9>(p, grid_blocks, stream); launch_phase<10>(p, grid_blocks, stream); launch_phase<11>(p, grid_blocks, stream);
#else
  (void)hipMemsetAsync((char*)d_ws + OFF_BAR, 0, 256, stream);
  void* args[] = {&p};
  hipError_t e = hipLaunchCooperativeKernel((const void*)mega<-1>, dim3(grid_blocks), dim3(NT), args, SMEM_BYTES, stream);
  if (e != hipSuccess) fprintf(stderr, "cooperative launch failed: %s (grid %d)\n", hipGetErrorString(e), grid_blocks);
#endif
}
```
